# Optimizing an MI355X kernel written in HIP

```python
import math
import jax
import jax.numpy as jnp
from jax import lax
import numpy as np

D_MODEL = 1024
BATCH = 8
SEQ = 2048
DEPTH = 2

GRID_W = 64
CTX_LEN = 256
ROPE_THETA = 10000.0
NORM_EPS = 1e-6
LB_FLOOR = 1e-30
Q_BLOCK = 128
CHUNK = 64

DA_HEADS = 4
DA_QK_DIM = 64
DA_V_DIM = 2 * DA_QK_DIM
HG_HEADS = 4
HG_K_DIM = 64
HG_V_DIM = 64
GD_HEADS = 4
GD_K_DIM = 64
GD_V_DIM = 64
GD_CONV = 3
FFN_CONV = 3
D_FF = 2816

DA_QK_W = DA_HEADS * 2 * DA_QK_DIM
DA_V_W = DA_HEADS * DA_V_DIM
HG_K_W = HG_HEADS * HG_K_DIM
HG_V_W = HG_HEADS * HG_V_DIM
GD_K_W = GD_HEADS * GD_K_DIM
GD_V_W = GD_HEADS * GD_V_DIM
MIX_W = DA_V_W + HG_V_W + GD_V_W
IN_SPLIT = (DA_QK_W, DA_QK_W, DA_V_W, HG_K_W, HG_V_W, 2 * HG_K_W, HG_V_W,
            2 * GD_K_W + GD_V_W, 2 * GD_HEADS, 2 * GD_HEADS, GD_V_W)
IN_COLS = sum(IN_SPLIT)
F32 = jnp.float32

kernel_name = "hybrid_diffattn_hgrn2_gdn_convffn_dit"


def rms_norm(x, g):
    xf = x.astype(F32)
    y = xf * lax.rsqrt(jnp.mean(xf * xf, axis=-1, keepdims=True) + NORM_EPS)
    return (y * g.astype(F32)).astype(x.dtype)


def l2_normalize(x):
    return x * lax.rsqrt(jnp.sum(x * x, axis=-1, keepdims=True) + NORM_EPS)


def modulate(h, shift, scale):
    return h * (1.0 + scale) + shift


def split_cols(p):
    return jnp.split(p, np.cumsum(IN_SPLIT)[:-1].tolist(), axis=-1)


def to_heads(x, n_heads):
    b, l, _ = x.shape
    return x.reshape(b, l, n_heads, -1).transpose(0, 2, 1, 3)


def from_heads(x):
    b, h, l, d = x.shape
    return x.transpose(0, 2, 1, 3).reshape(b, l, h * d)


def depthwise_conv(x, w):
    k, l = w.shape[0], x.shape[1]
    xp = jnp.pad(x, ((0, 0), (k // 2, k // 2), (0, 0)))
    return sum(xp[:, j:j + l] * w[j] for j in range(k))


def masked_decay(diff, mask):
    return jnp.where(mask, jnp.exp(jnp.minimum(diff, 0.0)), 0.0)


def axial_rope_tables(n_rows):
    n_freq = DA_QK_DIM // 4
    inv = ROPE_THETA ** (-jnp.arange(n_freq, dtype=F32) / n_freq)
    rows = jnp.repeat(jnp.arange(n_rows, dtype=F32), GRID_W)
    cols = jnp.tile(jnp.arange(GRID_W, dtype=F32), n_rows)
    ang = jnp.concatenate([rows[:, None] * inv, cols[:, None] * inv], axis=-1)
    return jnp.cos(ang), jnp.sin(ang)


def apply_rope(x, cos, sin):
    xa, xb = jnp.split(x, 2, axis=-1)
    return jnp.concatenate([xa * cos - xb * sin, xb * cos + xa * sin], axis=-1).astype(x.dtype)


def diff_softmax_attend(q, k, v, lam):
    s = jnp.einsum('bhmqd,bhmkd->bhmqk', q, k).astype(F32) * DA_QK_DIM ** -0.5
    p = jax.nn.softmax(s, axis=-1)
    w = p[:, :, 0] - lam * p[:, :, 1]
    return jnp.einsum('bhqk,bhkd->bhqd', w.astype(v.dtype), v)


def blocked_diff_attend(q, k, v, lam):
    b, h, m, l, d = q.shape
    nb = l // Q_BLOCK
    qb = jnp.moveaxis(q.reshape(b, h, m, nb, Q_BLOCK, d), 3, 0)
    o = lax.map(lambda qi: diff_softmax_attend(qi, k, v, lam), qb)
    return jnp.moveaxis(o, 0, 2).reshape(b, h, l, -1)


def diff_attention_mixer(q_l, k_l, v_l, q_c, k_c, v_c, lam_p, subln_g, lam_init, cos, sin, need_ctx):
    def qk_heads(p):
        b, l, _ = p.shape
        return p.reshape(b, l, DA_HEADS, 2, DA_QK_DIM).transpose(0, 2, 3, 1, 4)

    ql = apply_rope(qk_heads(q_l), cos, sin)
    kl = apply_rope(qk_heads(k_l), cos, sin)
    kc = qk_heads(k_c)
    vl, vc = to_heads(v_l, DA_HEADS), to_heads(v_c, DA_HEADS)
    lp = lam_p.astype(F32)
    lam = jnp.exp(jnp.sum(lp[0] * lp[1])) - jnp.exp(jnp.sum(lp[2] * lp[3])) + lam_init

    def finish(o):
        return from_heads(rms_norm(o, subln_g) * (1.0 - lam_init))

    k_all = jnp.concatenate([kc, kl], axis=3)
    v_all = jnp.concatenate([vc, vl], axis=2)
    o_lat = finish(blocked_diff_attend(ql, k_all, v_all, lam))
    o_ctx = finish(diff_softmax_attend(qk_heads(q_c), kc, vc, lam)) if need_ctx else None
    return o_lat, o_ctx


def chunk_scan(step, s0, seqs):
    l = seqs[0].shape[2]
    n = l // CHUNK

    def to_chunks(a):
        return jnp.moveaxis(a.reshape(a.shape[:2] + (n, CHUNK) + a.shape[3:]), 2, 0)

    s_final, o = lax.scan(step, s0, tuple(to_chunks(a) for a in seqs))
    o = jnp.moveaxis(o, 0, 2)
    return o.reshape(o.shape[:2] + (l,) + o.shape[4:]), s_final


def flip_time(seqs):
    return tuple(jnp.flip(a, axis=2) for a in seqs)


def bidirectional_scan(step, s0, ctx_fwd, lat_fwd, ctx_bwd, lat_bwd):
    o_cf, s_cf = chunk_scan(step, s0, ctx_fwd)
    o_lf, _ = chunk_scan(step, s_cf, lat_fwd)
    o_cb, s_cb = chunk_scan(step, s0, flip_time(ctx_bwd))
    o_lb, _ = chunk_scan(step, s_cb, flip_time(lat_bwd))
    return o_lf + jnp.flip(o_lb, axis=2), o_cf + jnp.flip(o_cb, axis=2)


def hgrn2_chunk_step(state, inp):
    q, k, v, log_f = inp
    c = q.shape[2]
    lower = jnp.tril(jnp.ones((c, c), dtype=bool))[:, :, None]
    b = jnp.cumsum(log_f, axis=2)
    decay = masked_decay(b[:, :, :, None, :] - b[:, :, None, :, :], lower)
    scores = jnp.einsum('bhtd,bhsd,bhtsd->bhts', q, k, decay)
    out = jnp.einsum('bhtd,bhde->bhte', q * jnp.exp(b), state) + jnp.einsum('bhts,bhse->bhte', scores, v)
    b_last = b[:, :, -1:, :]
    state = jnp.exp(b_last[:, :, 0, :])[..., None] * state + jnp.einsum('bhsd,bhse->bhde', k * jnp.exp(b_last - b), v)
    return state, out


def hgrn2_mixer(q_l, i_l, f_l, g_l, q_c, i_c, f_c, g_c, lb, norm_g, need_ctx):
    lbh = lb.astype(F32).reshape(1, 2, HG_HEADS, 1, HG_K_DIM)
    log_lb = jnp.log(jnp.maximum(lbh, LB_FLOOR))
    log_1m_lb = jnp.log1p(-lbh)

    def prep(q, i, f):
        qh = to_heads(jax.nn.silu(q), HG_HEADS).astype(F32)
        vh = to_heads(i, HG_HEADS).astype(F32)
        z = to_heads(f, 2 * HG_HEADS).astype(F32).reshape(f.shape[0], 2, HG_HEADS, f.shape[1], HG_K_DIM)
        k = (1.0 - lbh) * jax.nn.sigmoid(-z)
        log_f = jnp.logaddexp(log_lb, log_1m_lb + jax.nn.log_sigmoid(z))
        return tuple((qh, k[:, d], vh, log_f[:, d]) for d in range(2))

    fwd_c, bwd_c = prep(q_c, i_c, f_c)
    fwd_l, bwd_l = prep(q_l, i_l, f_l)
    s0 = jnp.zeros((q_l.shape[0], HG_HEADS, HG_K_DIM, HG_V_DIM), F32)
    o_l, o_c = bidirectional_scan(hgrn2_chunk_step, s0, fwd_c, fwd_l, bwd_c, bwd_l)

    def finish(o, g):
        return from_heads(rms_norm(o, norm_g)).astype(g.dtype) * jax.nn.silu(g)

    return finish(o_l, g_l), (finish(o_c, g_c) if need_ctx else None)


def gdn_chunk_step(state, inp):
    q, k, v, log_alpha, beta = inp
    c = q.shape[2]
    lower = jnp.tril(jnp.ones((c, c), dtype=bool))
    strict = jnp.tril(jnp.ones((c, c), dtype=bool), -1)
    gc = jnp.cumsum(log_alpha, axis=-1)
    decay = masked_decay(gc[..., :, None] - gc[..., None, :], lower)
    kk = jnp.einsum('bhtd,bhsd->bhts', k, k)
    tri = jnp.eye(c, dtype=q.dtype) + jnp.where(strict, beta[..., :, None] * kk * decay, 0.0)
    rhs = jnp.concatenate([v * beta[..., None], k * (beta * jnp.exp(gc))[..., None]], axis=-1)
    sol = lax.linalg.triangular_solve(tri, rhs, left_side=True, lower=True, unit_diagonal=True)
    dv = v.shape[-1]
    u, w = sol[..., :dv], sol[..., dv:]
    v_new = u - jnp.einsum('bhtd,bhde->bhte', w, state)
    scores = jnp.einsum('bhtd,bhsd->bhts', q, k) * decay
    out = jnp.einsum('bhtd,bhde->bhte', q * jnp.exp(gc)[..., None], state) + jnp.einsum('bhts,bhse->bhte', scores, v_new)
    g_last = gc[..., -1:]
    state = jnp.exp(g_last)[..., None] * state + jnp.einsum('bhsd,bhse->bhde', k * jnp.exp(g_last - gc)[..., None], v_new)
    return state, out


def gated_deltanet_mixer(qkv_l, a_l, b_l, g_l, qkv_c, a_c, b_c, g_c, conv_w, a_log, dt_bias, norm_g, need_ctx):
    def prep(qkv, a_in, b_in):
        qkv = jax.nn.silu(depthwise_conv(qkv, conv_w))
        q, k, v = jnp.split(qkv, [GD_K_W, 2 * GD_K_W], axis=-1)
        qh = l2_normalize(to_heads(q, GD_HEADS).astype(F32)) * GD_K_DIM ** -0.5
        kh = l2_normalize(to_heads(k, GD_HEADS).astype(F32))
        vh = to_heads(v, GD_HEADS).astype(F32)
        bsz, l = a_in.shape[0], a_in.shape[1]
        a_t = jnp.swapaxes(a_in.astype(F32), 1, 2).reshape(bsz, 2, GD_HEADS, l)
        beta = jax.nn.sigmoid(jnp.swapaxes(b_in.astype(F32), 1, 2).reshape(bsz, 2, GD_HEADS, l))
        log_alpha = -jnp.exp(a_log.astype(F32))[None, :, :, None] * jax.nn.softplus(a_t + dt_bias.astype(F32)[None, :, :, None])
        return tuple((qh, kh, vh, log_alpha[:, d], beta[:, d]) for d in range(2))

    fwd_c, bwd_c = prep(qkv_c, a_c, b_c)
    fwd_l, bwd_l = prep(qkv_l, a_l, b_l)
    s0 = jnp.zeros((qkv_l.shape[0], GD_HEADS, GD_K_DIM, GD_V_DIM), F32)
    o_l, o_c = bidirectional_scan(gdn_chunk_step, s0, fwd_c, fwd_l, bwd_c, bwd_l)

    def finish(o, g):
        return from_heads(rms_norm(o, norm_g)).astype(g.dtype) * jax.nn.silu(g)

    return finish(o_l, g_l), (finish(o_c, g_c) if need_ctx else None)


def conv_ffn(h, w_up, conv_w, conv_b, w_down):
    u = depthwise_conv(h @ w_up, conv_w) + conv_b
    gate, val = jnp.split(u, 2, axis=-1)
    return (jax.nn.silu(gate) * val) @ w_down


def setup_inputs(seed: int = 0) -> dict:
    key = jax.random.key(seed)
    ks = jax.random.split(key, 24)

    def nrm(k, shape, s):
        return jax.random.normal(k, shape, F32) * s

    dt = jnp.exp(jax.random.uniform(ks[15], (DEPTH, 2, GD_HEADS), F32, math.log(1e-3), math.log(1e-1)))
    return {
        'x': nrm(ks[0], (BATCH, SEQ, D_MODEL), 1.0),
        'c': nrm(ks[1], (BATCH, D_MODEL), 1.0),
        'ctx': nrm(ks[2], (BATCH, CTX_LEN, D_MODEL), 1.0),
        'c_ctx': nrm(ks[3], (D_MODEL,), 1.0),
        'ada_w': nrm(ks[4], (DEPTH, D_MODEL, 6 * D_MODEL), 0.5 * D_MODEL ** -0.5),
        'ada_b': nrm(ks[5], (DEPTH, 6 * D_MODEL), 0.01),
        'norm_g': 1.0 + nrm(ks[6], (DEPTH, 4, D_MODEL), 0.02),
        'w_in': nrm(ks[7], (DEPTH, D_MODEL, IN_COLS), D_MODEL ** -0.5),
        'w_out': nrm(ks[8], (DEPTH, MIX_W, D_MODEL), MIX_W ** -0.5),
        'da_lambda': nrm(ks[9], (DEPTH, 4, DA_QK_DIM), 0.1),
        'da_subln_g': 1.0 + nrm(ks[10], (DEPTH, DA_V_DIM), 0.02),
        'hg_lb_logits': nrm(ks[11], (DEPTH, 2, HG_K_W), 0.1),
        'hg_norm_g': 1.0 + nrm(ks[12], (DEPTH, HG_V_DIM), 0.02),
        'gd_conv_w': nrm(ks[13], (DEPTH, GD_CONV, 2 * GD_K_W + GD_V_W), GD_CONV ** -0.5),
        'gd_a_log': jnp.log(jax.random.uniform(ks[14], (DEPTH, 2, GD_HEADS), F32, 1.0, 16.0)),
        'gd_dt_bias': dt + jnp.log(-jnp.expm1(-dt)),
        'gd_norm_g': 1.0 + nrm(ks[16], (DEPTH, GD_V_DIM), 0.02),
        'ffn_w_up': nrm(ks[17], (DEPTH, D_MODEL, 2 * D_FF), D_MODEL ** -0.5),
        'ffn_conv_w': nrm(ks[18], (DEPTH, FFN_CONV, 2 * D_FF), FFN_CONV ** -0.5),
        'ffn_conv_b': nrm(ks[19], (DEPTH, 2 * D_FF), 0.01),
        'ffn_w_down': nrm(ks[20], (DEPTH, D_FF, D_MODEL), D_FF ** -0.5),
    }


def reference(x, c, ctx, c_ctx, ada_w, ada_b, norm_g, w_in, w_out, da_lambda, da_subln_g,
              hg_lb_logits, hg_norm_g, gd_conv_w, gd_a_log, gd_dt_bias, gd_norm_g,
              ffn_w_up, ffn_conv_w, ffn_conv_b, ffn_w_down):
    n_rows = x.shape[1] // GRID_W
    cos, sin = axial_rope_tables(n_rows)
    lb_w = jax.nn.softmax(hg_lb_logits.astype(F32), axis=0)
    lb_all = jnp.cumsum(lb_w, axis=0) - lb_w[0]
    cond_lat = jax.nn.silu(c)[:, None, :]
    cond_ctx = jax.nn.silu(c_ctx)
    h_ctx = ctx
    for layer in range(DEPTH):
        need_ctx = layer < DEPTH - 1
        lam_init = 0.8 - 0.6 * math.exp(-0.3 * layer)
        mod_l = jnp.split(cond_lat @ ada_w[layer] + ada_b[layer], 6, axis=-1)
        mod_c = jnp.split(cond_ctx @ ada_w[layer] + ada_b[layer], 6, axis=-1)

        p_l = split_cols(modulate(rms_norm(x, norm_g[layer, 0]), mod_l[0], mod_l[1]) @ w_in[layer])
        p_c = split_cols(modulate(rms_norm(h_ctx, norm_g[layer, 0]), mod_c[0], mod_c[1]) @ w_in[layer])
        oa_l, oa_c = diff_attention_mixer(p_l[0], p_l[1], p_l[2], p_c[0], p_c[1], p_c[2],
                                          da_lambda[layer], da_subln_g[layer], lam_init, cos, sin, need_ctx)
        ob_l, ob_c = hgrn2_mixer(p_l[3], p_l[4], p_l[5], p_l[6], p_c[3], p_c[4], p_c[5], p_c[6],
                                 lb_all[layer], hg_norm_g[layer], need_ctx)
        oc_l, oc_c = gated_deltanet_mixer(p_l[7], p_l[8], p_l[9], p_l[10], p_c[7], p_c[8], p_c[9], p_c[10],
                                          gd_conv_w[layer], gd_a_log[layer], gd_dt_bias[layer], gd_norm_g[layer], need_ctx)
        mix_l = jnp.concatenate([oa_l, ob_l, oc_l], axis=-1) @ w_out[layer]
        x = x + mod_l[2] * rms_norm(mix_l, norm_g[layer, 1])

        ff_l = conv_ffn(modulate(rms_norm(x, norm_g[layer, 2]), mod_l[3], mod_l[4]),
                        ffn_w_up[layer], ffn_conv_w[layer], ffn_conv_b[layer], ffn_w_down[layer])
        x = x + mod_l[5] * rms_norm(ff_l, norm_g[layer, 3])

        if need_ctx:
            mix_c = jnp.concatenate([oa_c, ob_c, oc_c], axis=-1) @ w_out[layer]
            h_ctx = h_ctx + mod_c[2] * rms_norm(mix_c, norm_g[layer, 1])
            ff_c = conv_ffn(modulate(rms_norm(h_ctx, norm_g[layer, 2]), mod_c[3], mod_c[4]),
                            ffn_w_up[layer], ffn_conv_w[layer], ffn_conv_b[layer], ffn_w_down[layer])
            h_ctx = h_ctx + mod_c[5] * rms_norm(ff_c, norm_g[layer, 3])
    return x
```

```cpp
#include <hip/hip_runtime.h>
#include <hip/hip_cooperative_groups.h>
#include <cstdio>
namespace cg = cooperative_groups;

typedef unsigned short bf16_t;
using bf16x8 = __attribute__((ext_vector_type(8))) short;
using f32x4 = __attribute__((ext_vector_type(4))) float;
using u32x4 = __attribute__((ext_vector_type(4))) unsigned;
using u32x2 = __attribute__((ext_vector_type(2))) unsigned;
#define DI __device__ __forceinline__
DI int tidx() { int t = threadIdx.x; asm volatile("" : "+v"(t)); return t; }
DI int bidx() { int t = blockIdx.x; asm volatile("" : "+s"(t)); return t; }
DI u32x4 mk4(unsigned a, unsigned b, unsigned c, unsigned d) { u32x4 r = {a, b, c, d}; return r; }
DI u32x2 mk2(unsigned a, unsigned b) { u32x2 r = {a, b}; return r; }

constexpr int D = 1024, NB = 8, SEQ = 2048, CTXL = 256;
constexpr int NLAT = NB * SEQ, NCTX = NB * CTXL, NROW = NLAT + NCTX;
constexpr int INC = 3856, PW = 3344, DFF = 2816, NKEY = 2304;
constexpr int PC_Q = 0, PC_K = 512, PC_HQ = 1024, PC_HI = 1280, PC_HF = 1536, PC_HG = 2048, PC_GQKV = 2304, PC_GA = 3072, PC_GB = 3080, PC_GG = 3088;
constexpr int SMEM_BYTES = 131072;
constexpr int LDS_TOTAL = SMEM_BYTES + 64;
constexpr int NTHR = 512, NWAVE = 8;
constexpr int INW = 3584;
constexpr int NPHASE = 20;

struct Params {
  const float *x, *c, *ctx, *c_ctx, *ada_w, *ada_b, *norm_g, *w_in, *w_out, *da_lambda, *da_subln_g,
      *hg_lb_logits, *hg_norm_g, *gd_conv_w, *gd_a_log, *gd_dt_bias, *gd_norm_g, *ffn_w_up, *ffn_conv_w, *ffn_conv_b, *ffn_w_down;
  float* out;
  bf16_t *WinT, *WvT, *WoutT, *WupT, *WdownT;
  float *mod, *ropec, *ropes, *cx;
  bf16_t *Abuf, *P, *Vt, *raw;
  bf16_t* mix;
  bf16_t* act;
  unsigned* bar;
  int phase_begin, phase_end;
};

typedef __bf16 hbf2 __attribute__((ext_vector_type(2)));
typedef float f32x2 __attribute__((ext_vector_type(2)));
DI unsigned pack2(float a, float b) { f32x2 v = {a, b}; hbf2 r = __builtin_convertvector(v, hbf2); return __builtin_bit_cast(unsigned, r); }
DI bf16_t f2bf(float x) { return (bf16_t)(pack2(x, x) & 0xffffu); }
DI float bf2f(bf16_t h) { return __uint_as_float(((unsigned)h) << 16); }
DI float silu_f(float x) { return x / (1.f + __expf(-x)); }
DI float sigmoid_f(float x) { return 1.f / (1.f + __expf(-x)); }
DI float quad_sum(float v) {
  int i = __float_as_int(v);
  v += __int_as_float(__builtin_amdgcn_update_dpp(0, i, 0xB1, 0xF, 0xF, true));
  i = __float_as_int(v);
  v += __int_as_float(__builtin_amdgcn_update_dpp(0, i, 0x4E, 0xF, 0xF, true));
  return v;
}
DI void unpack8(u32x4 u, float* f) {
  f[0] = __uint_as_float(u.x << 16); f[1] = __uint_as_float(u.x & 0xffff0000u);
  f[2] = __uint_as_float(u.y << 16); f[3] = __uint_as_float(u.y & 0xffff0000u);
  f[4] = __uint_as_float(u.z << 16); f[5] = __uint_as_float(u.z & 0xffff0000u);
  f[6] = __uint_as_float(u.w << 16); f[7] = __uint_as_float(u.w & 0xffff0000u);
}


#define XB_TMO      128
#define XB_XCNT(j)  (256  + 64 * (j))
#define XB_XSUB(j)  (1280 + 64 * (j))
#define XB_XGEN(j)  (2304 + 64 * (j))
#define XB_TOP      3328
#define XB_TOPGEN   3392
#define XCD_BAR_WORDS 3456
#define XB_QUEUE(l) (3456 + 64 * (l))
#define BAR_WORDS_TOTAL 3712
#define XB_SPIN_CAP (1u << 23)
#define LAS __attribute__((address_space(3)))
DI unsigned xb_ld(unsigned* p) { return __hip_atomic_load(p, __ATOMIC_RELAXED, __HIP_MEMORY_SCOPE_AGENT); }
DI unsigned xb_add(unsigned* p, unsigned v) { return __hip_atomic_fetch_add(p, v, __ATOMIC_RELAXED, __HIP_MEMORY_SCOPE_AGENT); }
DI unsigned xb_xcc_id() { return (unsigned)__builtin_amdgcn_s_getreg((3 << 11) | 20) & 0xFu; }
#define XB_SPIN(cond, bar) do { unsigned _sp = 0; while (cond) { __builtin_amdgcn_s_sleep(1); \
    if ((++_sp & 255u) == 0u) { if (xb_ld(&(bar)[XB_TMO])) break; if (_sp > XB_SPIN_CAP) { atomicAdd(&(bar)[XB_TMO], 1u); break; } } } } while (0)
struct XcdBarrier { unsigned* bar; unsigned x; volatile LAS unsigned* st; };
DI XcdBarrier xcd_barrier_post(unsigned* bar, volatile LAS unsigned* st) {
  XcdBarrier b; b.bar = bar; b.x = xb_xcc_id(); b.st = st;
  if (threadIdx.x == 0) (void)xb_add(&bar[XB_XCNT(b.x)], 1u);
  return b;
}
DI void xcd_barrier_complete(unsigned* bar, unsigned x, unsigned& nloc, unsigned& nx) {
  const unsigned G = gridDim.x * gridDim.y * gridDim.z;
  unsigned sum, cnt, mine, sp = 0u;
  for (;;) {
    sum = 0u; cnt = 0u; mine = 0u;
#pragma unroll
    for (unsigned j = 0; j < 16; ++j) { const unsigned c = xb_ld(&bar[XB_XCNT(j)]); sum += c; cnt += (c > 0u) ? 1u : 0u; mine = (j == x) ? c : mine; }
    if (sum == G) break;
    __builtin_amdgcn_s_sleep(1);
    if ((++sp & 255u) == 0u) { if (xb_ld(&bar[XB_TMO])) break; if (sp > XB_SPIN_CAP) { atomicAdd(&bar[XB_TMO], 1u); break; } }
  }
  nloc = mine > 0u ? mine : 1u; nx = cnt > 0u ? cnt : 1u;
}
DI void xcd_barrier(const XcdBarrier& b) {
  asm volatile("s_waitcnt vmcnt(0)" ::: "memory");
  __syncthreads();
  if (threadIdx.x == 0) {
    unsigned* bar = b.bar;
    __builtin_amdgcn_s_waitcnt(0);
    unsigned nloc = b.st[0], nx = b.st[1];
    if (nloc == 0u) { xcd_barrier_complete(bar, b.x, nloc, nx); b.st[0] = nloc; b.st[1] = nx; }
    const unsigned old = xb_add(&bar[XB_XSUB(b.x)], 1u);
    const unsigned gen = old / nloc;
    if (old + 1u == (gen + 1u) * nloc) {
      __builtin_amdgcn_fence(__ATOMIC_RELEASE, "agent");
      asm volatile("s_waitcnt vmcnt(0)" ::: "memory");
      const unsigned og = xb_add(&bar[XB_TOP], 1u);
      const unsigned tg = og / nx;
      if (og + 1u == (tg + 1u) * nx) xb_add(&bar[XB_TOPGEN], 1u);
      else XB_SPIN(xb_ld(&bar[XB_TOPGEN]) == tg, bar);
      __builtin_amdgcn_fence(__ATOMIC_ACQUIRE, "agent");
      xb_add(&bar[XB_XGEN(b.x)], 1u);
      asm volatile("s_waitcnt vmcnt(0)" ::: "memory");
    } else {
      XB_SPIN(xb_ld(&bar[XB_XGEN(b.x)]) == gen, bar);
      __builtin_amdgcn_fence(__ATOMIC_ACQUIRE, "agent");
      asm volatile("s_waitcnt vmcnt(0)" ::: "memory");
    }
  }
  __syncthreads();
}

DI void transpose_tile(const float* __restrict__ W, int K, int N, bf16_t* __restrict__ WT, bf16_t* __restrict__ WT2, int kt, int nt, int mode, float* lds, bool valid) {
  const int tid = tidx() & 255;
  const int k0 = kt * 64, n0 = nt * 64;
  if (valid) {
#pragma unroll
    for (int pp = 0; pp < 4; ++pp) {
      int r = pp * 16 + (tid >> 4), c = (tid & 15) * 4;
      float4 v = make_float4(0.f, 0.f, 0.f, 0.f);
      int n = n0 + c;
      if (n + 3 < N) { const f32x4 t4 = __builtin_nontemporal_load((const f32x4*)(W + (size_t)(k0 + r) * N + n)); v = make_float4(t4[0], t4[1], t4[2], t4[3]); }
      lds[r * 65 + c + 0] = v.x; lds[r * 65 + c + 1] = v.y; lds[r * 65 + c + 2] = v.z; lds[r * 65 + c + 3] = v.w;
    }
  }
  __syncthreads();
  if (valid) {
    int nl = tid >> 2, kq = tid & 3;
    int n = n0 + nl;
    bf16_t* dstbase = WT;
    int orow = n;
    if (mode == 1) orow = (n < DFF) ? ((n >> 7) * 256 + (n & 127)) : (((n - DFF) >> 7) * 256 + 128 + ((n - DFF) & 127));
    if (mode == 2) {
      if (n < 1024) { const int d = n & 63; orow = (n & ~63) + (d < 32 ? 2 * d : 2 * (d - 32) + 1); }
      else if (n < 1536) { orow = n - 1024; dstbase = WT2; }
      else orow = n - 512;
    }
    if (n < N) {
      unsigned w[8];
#pragma unroll
      for (int i = 0; i < 8; ++i) w[i] = pack2(lds[(kq * 16 + 2 * i) * 65 + nl], lds[(kq * 16 + 2 * i + 1) * 65 + nl]);
      u32x4* dst = (u32x4*)(dstbase + (size_t)orow * K + k0 + kq * 16);
      dst[0] = mk4(w[0], w[1], w[2], w[3]);
      dst[1] = mk4(w[4], w[5], w[6], w[7]);
    }
  }
  __syncthreads();
}

constexpr int WT_IN = 16 * 61, WT_OUT = 16 * 16, WT_UP = 16 * 88, WT_DOWN = 44 * 16;
constexpr int WT_ITEMS = WT_IN + WT_OUT + WT_UP + WT_DOWN;
constexpr int WPRE = 112 * 7;
DI void weight_item(const Params& p, int layer, int it, float* lds, bool valid) {
  if (it < WT_IN) { transpose_tile(p.w_in + (size_t)layer * D * INC, D, INC, p.WinT, p.WvT, it % 16, it / 16, 2, lds, valid); return; }
  it -= WT_IN;
  if (it < WT_OUT) { transpose_tile(p.w_out + (size_t)layer * D * D, D, D, p.WoutT, nullptr, it % 16, it / 16, 0, lds, valid); return; }
  it -= WT_OUT;
  if (it < WT_UP) { transpose_tile(p.ffn_w_up + (size_t)layer * D * 2 * DFF, D, 2 * DFF, p.WupT, nullptr, it % 16, it / 16, 1, lds, valid); return; }
  it -= WT_UP;
  transpose_tile(p.ffn_w_down + (size_t)layer * DFF * D, DFF, D, p.WdownT, nullptr, it % 44, it / 44, 0, lds, valid);
}
DI void weight_pair(const Params& p, int layer, int first, int last, int pair, char* smem) {
  const int half = tidx() >> 8;
  float* lds = (float*)smem + half * 4224;
  const int it = first + pair * 2 + half;
  const bool valid = it < last;
  weight_item(p, layer, valid ? it : last - 1, lds, valid);
}

DI void mod_item(const Params& p, int it2, float* lds) {
  const int tid = tidx() & 255, half = tidx() >> 8;
  const int it = it2 * 2 + half;
  const int layer = it / 192, n0 = (it % 192) * 32;
  float* sc = lds;
  float* red = lds + 9 * 1024 + half * 2304;
  for (int i = tidx(); i < 9 * 1024; i += NTHR) {
    float v = (i < 8 * 1024) ? p.c[i] : p.c_ctx[i - 8 * 1024];
    sc[i] = silu_f(v);
  }
  __syncthreads();
  const int kg = tid >> 5, col = tid & 31;
  float acc[9];
#pragma unroll
  for (int i = 0; i < 9; ++i) acc[i] = 0.f;
  const float* w = p.ada_w + (size_t)layer * D * 6144 + n0 + col;
#pragma unroll 8
  for (int k = kg * 128; k < kg * 128 + 128; ++k) {
    float wv = __builtin_nontemporal_load(w + (size_t)k * 6144);
#pragma unroll
    for (int i = 0; i < 9; ++i) acc[i] += sc[i * 1024 + k] * wv;
  }
#pragma unroll
  for (int i = 0; i < 9; ++i) red[(kg * 9 + i) * 32 + col] = acc[i];
  __syncthreads();
  for (int t = tid; t < 288; t += 256) {
    int i = t >> 5, cc = t & 31;
    float sacc = p.ada_b[layer * 6144 + n0 + cc];
#pragma unroll
    for (int g = 0; g < 8; ++g) sacc += red[(g * 9 + i) * 32 + cc];
    p.mod[(size_t)(layer * 9 + i) * 6144 + n0 + cc] = sacc;
  }
  __syncthreads();
}

DI void rope_item(const Params& p, int it) {
  for (int i = 0; i < 2; ++i) {
    int idx = it * 1024 + i * 512 + tidx();
    int t = idx >> 5, j = idx & 31;
    float pos = (float)((j < 16) ? (t >> 6) : (t & 63));
    float inv = exp2f(-(float)(j & 15) * (13.287712379549449f / 16.f));
    float ang = pos * inv;
    double rev = (double)ang * 0.15915494309189535;
    rev -= floor(rev);
    float fr = (float)rev;
    p.ropec[idx] = __builtin_amdgcn_cosf(fr);
    p.ropes[idx] = __builtin_amdgcn_sinf(fr);
  }
}

DI float wave_sum(float v) {
#pragma unroll
  for (int o = 32; o >= 1; o >>= 1) v += __shfl_xor(v, o);
  return v;
}
DI void update_phase(const Params& p, int layer, int which, int mode, int bofs, int nb) {
  const int lane = tidx() & 63, wid = tidx() >> 6;
  const int nrows = (layer == 1) ? NLAT : NROW;
  const bool last = (layer == 1 && which == 2);
  const int gw = (bidx() - bofs) * NWAVE + wid, nw = nb * NWAVE;
  const int nl = (which == 2) ? layer + 1 : layer;
  const int gi = (which == 1) ? 2 : 0, sh = (which == 1) ? 3 : 0;
  const bool from_in = (layer == 0 && which <= 1);
  float4 pg[4], pgt[4], ng[4], nsf[4], nsc[4];
  auto load_params = [&](int mi) {
    const float* modp = p.mod + (size_t)(layer * 9 + mi) * 6144;
    const float* gate = modp + (which == 1 ? 2 : 5) * 1024;
    const float* gp = p.norm_g + (size_t)(layer * 4 + (which == 1 ? 1 : 3)) * 1024;
    const float* modn = p.mod + (size_t)(nl * 9 + mi) * 6144;
    const float* gn = p.norm_g + (size_t)(nl * 4 + gi) * 1024;
#pragma unroll
    for (int i = 0; i < 4; ++i) {
      if (which != 0) { pg[i] = *(const float4*)(gp + i * 256 + lane * 4); pgt[i] = *(const float4*)(gate + i * 256 + lane * 4); }
      if (!last) {
        ng[i] = *(const float4*)(gn + i * 256 + lane * 4);
        nsf[i] = *(const float4*)(modn + sh * 1024 + i * 256 + lane * 4);
        nsc[i] = *(const float4*)(modn + (sh + 1) * 1024 + i * 256 + lane * 4);
      }
    }
  };
  auto row_src = [&](int r) -> const float* {
    if (r < NLAT) return from_in ? p.x + (size_t)r * D : p.out + (size_t)r * D;
    return from_in ? p.ctx + (size_t)(r - NLAT) * D : p.cx + (size_t)(r - NLAT) * D;
  };
  auto load_row = [&](int r, float4 (&xv)[4], u32x2 (&um)[4]) {
    const float* xs = row_src(r);
#pragma unroll
    for (int i = 0; i < 4; ++i) { const f32x4 t4 = __builtin_nontemporal_load((const f32x4*)(xs + i * 256 + lane * 4)); xv[i] = make_float4(t4[0], t4[1], t4[2], t4[3]); }
    if (which != 0) {
      const bf16_t* mr = p.mix + (size_t)r * D;
#pragma unroll
      for (int i = 0; i < 4; ++i) um[i] = __builtin_nontemporal_load((const u32x2*)(mr + i * 256 + lane * 4));
    }
  };
  auto do_row = [&](int r, float4 (&xv)[4], const u32x2 (&um)[4]) {
    float* xd = (r < NLAT) ? p.out + (size_t)r * D : p.cx + (size_t)(r - NLAT) * D;
    if (which != 0) {
      float4 mv[4];
      float ss = 0.f;
#pragma unroll
      for (int i = 0; i < 4; ++i) {
        mv[i] = make_float4(__uint_as_float(um[i].x << 16), __uint_as_float(um[i].x & 0xffff0000u), __uint_as_float(um[i].y << 16), __uint_as_float(um[i].y & 0xffff0000u));
        ss += mv[i].x * mv[i].x + mv[i].y * mv[i].y + mv[i].z * mv[i].z + mv[i].w * mv[i].w;
      }
      ss = wave_sum(ss);
      const float rstd = rsqrtf(ss * (1.f / 1024.f) + 1e-6f);
#pragma unroll
      for (int i = 0; i < 4; ++i) {
        xv[i].x += pgt[i].x * (mv[i].x * rstd * pg[i].x);
        xv[i].y += pgt[i].y * (mv[i].y * rstd * pg[i].y);
        xv[i].z += pgt[i].z * (mv[i].z * rstd * pg[i].z);
        xv[i].w += pgt[i].w * (mv[i].w * rstd * pg[i].w);
        { const f32x4 t4 = {xv[i].x, xv[i].y, xv[i].z, xv[i].w}; __builtin_nontemporal_store(t4, (f32x4*)(xd + i * 256 + lane * 4)); }
      }
    }
    if (!last) {
      float ss = 0.f;
#pragma unroll
      for (int i = 0; i < 4; ++i) ss += xv[i].x * xv[i].x + xv[i].y * xv[i].y + xv[i].z * xv[i].z + xv[i].w * xv[i].w;
      ss = wave_sum(ss);
      const float rstd = rsqrtf(ss * (1.f / 1024.f) + 1e-6f);
      bf16_t* dst = p.Abuf + (size_t)r * D;
#pragma unroll
      for (int i = 0; i < 4; ++i) {
        float a = (xv[i].x * rstd * ng[i].x) * (1.f + nsc[i].x) + nsf[i].x;
        float b = (xv[i].y * rstd * ng[i].y) * (1.f + nsc[i].y) + nsf[i].y;
        float c = (xv[i].z * rstd * ng[i].z) * (1.f + nsc[i].z) + nsf[i].z;
        float d = (xv[i].w * rstd * ng[i].w) * (1.f + nsc[i].w) + nsf[i].w;
        *(u32x2*)(dst + i * 256 + lane * 4) = mk2(pack2(a, b), pack2(c, d));
      }
    }
  };
  if (mode == 2) {
    float4 xa[4];
    u32x2 ma[4];
    load_params(8);
    for (int rc = NLAT + gw; rc < NROW; rc += nw) { load_row(rc, xa, ma); do_row(rc, xa, ma); }
  } else if ((nw & 7) == 0 && nw <= 8 * SEQ) {
    const int wpb = nw >> 3, bb = gw / wpb, wl = gw % wpb;
    load_params(bb);
    float4 xa[4], xb[4];
    u32x2 ma[4], mb[4];
    int r = bb * SEQ + wl;
    const int rend = (bb + 1) * SEQ;
    if (r < rend) load_row(r, xa, ma);
    while (r < rend) {
      const int r2 = r + wpb;
      if (r2 < rend) load_row(r2, xb, mb);
      do_row(r, xa, ma);
      if (r2 >= rend) break;
      const int r3 = r2 + wpb;
      if (r3 < rend) load_row(r3, xa, ma);
      do_row(r2, xb, mb);
      r = r3;
    }
    if (mode == 0 && nrows > NLAT) {
      load_params(8);
      for (int rc = NLAT + gw; rc < NROW; rc += nw) { load_row(rc, xa, ma); do_row(rc, xa, ma); }
    }
  } else {
    float4 xa[4];
    u32x2 ma[4];
    for (int r = gw; r < (mode == 1 ? NLAT : nrows); r += nw) { load_params((r < NLAT) ? (r >> 11) : 8); load_row(r, xa, ma); do_row(r, xa, ma); }
  }
}

constexpr int EPI_P = 0, EPI_MIX = 1, EPI_CONV = 2, EPI_VT = 3;
constexpr int G_BM = 256, G_BK = 64, G_HALF = 128, G_HTB = G_HALF * G_BK * 2, G_STAGE_BYTES = 8 * G_HTB, G_NXCD = 8, G_WGM = 8;
constexpr int HB_LAT = 34, HB_CTX = 5, HB_NLAT = NB * HB_LAT, HB_NCTX = NB * HB_CTX;
DI int g_lds_byte(int r, int c) { const int st = (r >> 4) * 2 + (c >> 5), rr = r & 15, cc = c & 31, ob = rr * 64 + cc * 2; return st * 1024 + (ob ^ (((ob >> 9) & 1) << 5)); }
DI void g_stage_rc(int b, int& R, int& C) { const int st = b / 1024, sb = b % 1024, swz = sb ^ (((sb >> 9) & 1) << 5); R = (st >> 1) * 16 + swz / 64; C = (st & 1) * 32 + (swz % 64) / 2; }
DI int g_perm32(int rho) { const int n = rho >> 4, i = rho & 15; return 8 * (i >> 2) + 4 * n + (i & 3); }
struct GUnit { int pm, pn; };
struct GOrder {
  int nM, nN, nwg, G, c;
  DI void init(int nM_, int nN_, int G_, int c_) { nM = nM_; nN = nN_; nwg = nM * nN; G = G_; c = c_; }
  DI bool next(int i, GUnit& u) const {
    const long L = (long)i * G + c; if (L >= nwg) return false;
    int wgid = (int)L; { const int q = nwg / G_NXCD, r = nwg % G_NXCD, xcd = wgid % G_NXCD, off = wgid / G_NXCD; wgid = (xcd < r ? xcd * (q + 1) : r * (q + 1) + (xcd - r) * q) + off; }
    const int nig = G_WGM * nN, gid = wgid / nig, fm = gid * G_WGM, gsz = (nM - fm) < G_WGM ? (nM - fm) : G_WGM;
    u.pm = fm + ((wgid % nig) % gsz); u.pn = (wgid % nig) / gsz; return true;
  }
};
DI void halo_block(int blk, int& base, int& L, int& t0) {
  if (blk < HB_NLAT) { const int s = blk / HB_LAT, i = blk % HB_LAT; base = s * SEQ; L = SEQ; t0 = 62 * i - 1; }
  else { const int b2 = blk - HB_NLAT; const int s = b2 / HB_CTX, i = b2 % HB_CTX; base = NLAT + s * CTXL; L = CTXL; t0 = 62 * i - 1; }
}
template <int AMODE>
DI void g_a_offsets(int pm, int K, const int (&R)[2], const int (&C)[2], unsigned (&o)[2][2]) {
#pragma unroll
  for (int h = 0; h < 2; ++h)
#pragma unroll
    for (int i = 0; i < 2; ++i) {
      const int tr = h * 128 + R[i];
      int grow;
      if (AMODE == 0) grow = pm * 256 + tr;
      else {
        int base, L, t0; halo_block(pm * 4 + (tr >> 6), base, L, t0);
        const int t = t0 + (tr & 63);
        grow = (t >= 0 && t < L) ? base + t : NROW;
      }
      o[h][i] = (unsigned)(grow * K + C[i]) * 2u;
    }
}

template <int EPI> DI void g_epilogue(const Params& p, int layer, const f32x4 (&acc)[2][2][4][2], const GUnit& u, int wr, int wc, int fr, int fq);

template <int EPI, int AMODE>
DI void gemm_phase(const Params& p, int layer, LAS unsigned char* lds, const bf16_t* A, const bf16_t* Bt, int K, int nM, int nN, int pm_base = 0, int Gov = 0, int cov = 0) {
  const int tid = tidx(), wid = __builtin_amdgcn_readfirstlane(tid >> 6), lane = tid & 63, wr = wid >> 2, wc = wid & 3, fr = lane & 15, fq = lane >> 4;
  const int nt = K / G_BK;
  int sR[2], sC[2];
  unsigned voffB[2];
#pragma unroll
  for (int i = 0; i < 2; ++i) { g_stage_rc(tid * 16 + i * 8192, sR[i], sC[i]); const int Rb = (sR[i] & ~31) + g_perm32(sR[i] & 31); voffB[i] = (unsigned)(Rb * K + sC[i]) * 2u; }
  const size_t kstep = (size_t)(G_BK * 2);
  const size_t hstep = (size_t)G_HALF * K * 2;
  const size_t tstep = 2 * hstep;
  const unsigned ldsw = (unsigned)wid * 1024u;
  const int aoff = g_lds_byte(wr * 64 + fr, fq * 8), boff = g_lds_byte(wc * 32 + fr, fq * 8);
  const char* gA = (const char*)A;
#define PG8_SA(b, h) (((b) * 2 + (h)) * G_HTB)
#define PG8_SB(b, h) ((4 + (b) * 2 + (h)) * G_HTB)
#define PG8_STAGE(bufoff, gbase, voff) do { _Pragma("unroll") for (int _i = 0; _i < 2; ++_i) \
    __builtin_amdgcn_global_load_lds((const unsigned*)((const char*)(gbase) + (voff)[_i]), (LAS unsigned*)(lds + (bufoff) + ldsw + _i * 8192), 16, 0, 0); } while (0)
#define PG8_LDA(dst, b, h) do { _Pragma("unroll") for (int m = 0; m < 4; ++m) _Pragma("unroll") for (int k = 0; k < 2; ++k) dst[m][k] = *(const LAS bf16x8*)(lds + PG8_SA(b, h) + aoff + m * 2048 + k * 1024); } while (0)
#define PG8_LDB(dst, b, h) do { _Pragma("unroll") for (int n = 0; n < 2; ++n) _Pragma("unroll") for (int k = 0; k < 2; ++k) dst[n][k] = *(const LAS bf16x8*)(lds + PG8_SB(b, h) + boff + n * 2048 + k * 1024); } while (0)
#define PG8_MMA(ai, bj, At, Bt_) do { __builtin_amdgcn_s_setprio(1); _Pragma("unroll") for (int m = 0; m < 4; ++m) _Pragma("unroll") for (int n = 0; n < 2; ++n) _Pragma("unroll") for (int k = 0; k < 2; ++k) \
    acc[ai][bj][m][n] = __builtin_amdgcn_mfma_f32_16x16x32_bf16(Bt_[n][k], At[m][k], acc[ai][bj][m][n], 0, 0, 0); __builtin_amdgcn_s_setprio(0); } while (0)
#define PG8_WAIT_V(n) asm volatile("s_waitcnt vmcnt(" #n ")" ::: "memory")
#define PG8_WAIT_L(n) asm volatile("s_waitcnt lgkmcnt(" #n ")" ::: "memory")
#define PG8_BAR __builtin_amdgcn_s_barrier()
#define PG8_SCHED __builtin_amdgcn_sched_barrier(0)
  GOrder S; S.init(nM, nN, Gov ? Gov : (int)gridDim.x, Gov ? cov : bidx());
  GUnit cur, nxt; int ui = 0;
  if (!S.next(0, cur)) return;
  cur.pm += pm_base;
  f32x4 acc[2][2][4][2];
#pragma unroll
  for (int a = 0; a < 2; ++a)
#pragma unroll
    for (int b = 0; b < 2; ++b)
#pragma unroll
      for (int m = 0; m < 4; ++m)
#pragma unroll
        for (int n = 0; n < 2; ++n) acc[a][b][m][n] = (f32x4){0.f, 0.f, 0.f, 0.f};
  bf16x8 At[4][2], B0[2][2], B1[2][2];
  unsigned curA[2][2];
  g_a_offsets<AMODE>(cur.pm, K, sR, sC, curA);
  const char* cB = (const char*)Bt + (size_t)cur.pn * tstep;
  PG8_STAGE(PG8_SB(0, 0), cB, voffB); PG8_STAGE(PG8_SA(0, 0), gA, curA[0]); PG8_STAGE(PG8_SB(0, 1), cB + hstep, voffB); PG8_STAGE(PG8_SA(0, 1), gA, curA[1]);
  if (wr == 1) PG8_BAR;
  PG8_WAIT_V(4); PG8_BAR;
  PG8_STAGE(PG8_SB(1, 0), cB + kstep, voffB); PG8_STAGE(PG8_SA(1, 0), gA + kstep, curA[0]); PG8_STAGE(PG8_SB(1, 1), cB + hstep + kstep, voffB);
  PG8_WAIT_V(6); PG8_BAR;
  for (;;) {
    {
      const int tid2 = tidx();
#pragma unroll
      for (int i = 0; i < 2; ++i) { g_stage_rc(tid2 * 16 + i * 8192, sR[i], sC[i]); const int Rb = (sR[i] & ~31) + g_perm32(sR[i] & 31); voffB[i] = (unsigned)(Rb * K + sC[i]) * 2u; }
      g_a_offsets<AMODE>(cur.pm, K, sR, sC, curA);
    }
    const bool has_next = S.next(ui + 1, nxt);
    if (has_next) nxt.pm += pm_base;
    const int npm = has_next ? nxt.pm : cur.pm;
    const char* nB = has_next ? (const char*)Bt + (size_t)nxt.pn * tstep : cB;
    for (int t = 0; t < nt; t += 2) {
      const bool last = (t == nt - 2);
      const char* a1 = gA + (size_t)(t + 1) * kstep;
      const char* a2 = last ? gA : gA + (size_t)(t + 2) * kstep;
      const char* b2 = last ? nB : cB + (size_t)(t + 2) * kstep;
      const char* a3 = a2 + kstep; const char* b3 = b2 + kstep;
      unsigned a2o[2][2];
      if (last) g_a_offsets<AMODE>(npm, K, sR, sC, a2o);
      else {
#pragma unroll
        for (int h = 0; h < 2; ++h)
#pragma unroll
          for (int i = 0; i < 2; ++i) a2o[h][i] = curA[h][i];
      }
      PG8_LDB(B0, 0, 0); PG8_SCHED; PG8_LDA(At, 0, 0); PG8_STAGE(PG8_SA(1, 1), a1, curA[1]);
      PG8_WAIT_L(8); PG8_BAR; PG8_WAIT_L(0); PG8_MMA(0, 0, At, B0); PG8_BAR; PG8_SCHED;
      PG8_LDB(B1, 0, 1); PG8_STAGE(PG8_SB(0, 0), b2, voffB);
      PG8_BAR; PG8_WAIT_L(0); PG8_MMA(0, 1, At, B1); PG8_BAR;
      PG8_LDA(At, 0, 1); PG8_STAGE(PG8_SA(0, 0), a2, a2o[0]);
      PG8_BAR; PG8_WAIT_L(0); PG8_MMA(1, 0, At, B0); PG8_BAR; PG8_SCHED;
      PG8_STAGE(PG8_SB(0, 1), b2 + hstep, voffB);
      PG8_WAIT_V(6); PG8_BAR; PG8_MMA(1, 1, At, B1); PG8_BAR;
      PG8_LDB(B0, 1, 0); PG8_SCHED; PG8_LDA(At, 1, 0); PG8_STAGE(PG8_SA(0, 1), a2, a2o[1]);
      PG8_WAIT_L(8); PG8_BAR; PG8_WAIT_L(0); PG8_MMA(0, 0, At, B0); PG8_BAR; PG8_SCHED;
      PG8_LDB(B1, 1, 1); PG8_STAGE(PG8_SB(1, 0), b3, voffB);
      PG8_BAR; PG8_WAIT_L(0); PG8_MMA(0, 1, At, B1); PG8_BAR;
      PG8_LDA(At, 1, 1); PG8_STAGE(PG8_SA(1, 0), a3, a2o[0]);
      PG8_BAR; PG8_WAIT_L(0); PG8_MMA(1, 0, At, B0); PG8_BAR; PG8_SCHED;
      PG8_STAGE(PG8_SB(1, 1), b3 + hstep, voffB);
      PG8_WAIT_V(6); PG8_BAR; PG8_MMA(1, 1, At, B1); PG8_BAR;
    }
    g_epilogue<EPI>(p, layer, acc, cur, wr, wc, fr, fq);
    if (!has_next) break;
#pragma unroll
    for (int a = 0; a < 2; ++a)
#pragma unroll
      for (int b = 0; b < 2; ++b)
#pragma unroll
        for (int m = 0; m < 4; ++m)
#pragma unroll
          for (int n = 0; n < 2; ++n) acc[a][b][m][n] = (f32x4){0.f, 0.f, 0.f, 0.f};
    cur = nxt; cB = nB; ++ui;
  }
  PG8_WAIT_V(0);
  if (wr == 0) PG8_BAR;
  PG8_BAR;
#undef PG8_SA
#undef PG8_SB
#undef PG8_STAGE
#undef PG8_LDA
#undef PG8_LDB
#undef PG8_MMA
#undef PG8_WAIT_V
#undef PG8_WAIT_L
#undef PG8_BAR
#undef PG8_SCHED
}

DI float dpp_ror1(float v) { return __int_as_float(__builtin_amdgcn_update_dpp(0, __float_as_int(v), 0x121, 0xF, 0xF, true)); }
DI float dpp_ror15(float v) { return __int_as_float(__builtin_amdgcn_update_dpp(0, __float_as_int(v), 0x12F, 0xF, 0xF, true)); }
template <int EPI>
DI void g_epilogue(const Params& p, int layer, const f32x4 (&acc)[2][2][4][2], const GUnit& u, int wr, int wc, int fr, int fq) {
  if (EPI == EPI_MIX) {
#pragma unroll
    for (int ai = 0; ai < 2; ++ai)
#pragma unroll
      for (int m = 0; m < 4; ++m) {
        bf16_t* rowp = p.mix + (size_t)(u.pm * 256 + ai * 128 + wr * 64 + m * 16 + fr) * D + u.pn * 256 + wc * 32 + 8 * fq;
#pragma unroll
        for (int bj = 0; bj < 2; ++bj) {
          const f32x4 v0 = acc[ai][bj][m][0], v1 = acc[ai][bj][m][1];
          *(u32x4*)(rowp + bj * 128) = mk4(pack2(v0[0], v0[1]), pack2(v0[2], v0[3]), pack2(v1[0], v1[1]), pack2(v1[2], v1[3]));
        }
      }
  } else if (EPI == EPI_P) {
    const bool is_lat = (u.pm * 256) < NLAT;
    const bool qk = u.pn < 4;
    const float qs = (u.pn < 2) ? (0.125f * 1.4426950408889634f) : 1.f;
#pragma unroll
    for (int ai = 0; ai < 2; ++ai)
#pragma unroll
      for (int m = 0; m < 4; ++m) {
        const int row = u.pm * 256 + ai * 128 + wr * 64 + m * 16 + fr;
        bf16_t* rowp = p.P + (size_t)row * PW + u.pn * 256 + wc * 32 + 8 * fq;
        f32x4 cs = {1.f, 1.f, 1.f, 1.f}, sn = {0.f, 0.f, 0.f, 0.f};
        if (qk && is_lat) {
          const int t = row & (SEQ - 1), d0 = (wc & 1) * 16 + 4 * fq;
          cs = *(const f32x4*)(p.ropec + t * 32 + d0);
          sn = *(const f32x4*)(p.ropes + t * 32 + d0);
        }
#pragma unroll
        for (int bj = 0; bj < 2; ++bj) {
          f32x4 v0 = acc[ai][bj][m][0], v1 = acc[ai][bj][m][1];
          if (qk) {
            const f32x4 w0 = {v0[0] * cs[0] - v0[1] * sn[0], v0[1] * cs[0] + v0[0] * sn[0], v0[2] * cs[1] - v0[3] * sn[1], v0[3] * cs[1] + v0[2] * sn[1]};
            const f32x4 w1 = {v1[0] * cs[2] - v1[1] * sn[2], v1[1] * cs[2] + v1[0] * sn[2], v1[2] * cs[3] - v1[3] * sn[3], v1[3] * cs[3] + v1[2] * sn[3]};
            v0 = w0 * qs; v1 = w1 * qs;
          }
          const int col = u.pn * 256 + bj * 128 + wc * 32 + 8 * fq;
          if (col < PW) *(u32x4*)(rowp + bj * 128) = mk4(pack2(v0[0], v0[1]), pack2(v0[2], v0[3]), pack2(v1[0], v1[1]), pack2(v1[2], v1[3]));
        }
      }
  } else if (EPI == EPI_VT) {
#pragma unroll
    for (int ai = 0; ai < 2; ++ai)
#pragma unroll
      for (int m = 0; m < 4; ++m) {
        const int hh = u.pm * 2 + ai, dv = wr * 64 + m * 16 + fr;
#pragma unroll
        for (int bj = 0; bj < 2; ++bj) {
          const int tok = u.pn * 256 + bj * 128 + wc * 32 + 8 * fq;
          int bb, key;
          if (tok < NLAT) { bb = tok >> 11; key = CTXL + (tok & (SEQ - 1)); } else { bb = (tok - NLAT) >> 8; key = (tok - NLAT) & (CTXL - 1); }
          const f32x4 v0 = acc[ai][bj][m][0], v1 = acc[ai][bj][m][1];
          *(u32x4*)(p.Vt + ((size_t)((bb * 4 + hh) * 128 + dv)) * NKEY + key) = mk4(pack2(v0[0], v0[1]), pack2(v0[2], v0[3]), pack2(v1[0], v1[1]), pack2(v1[2], v1[3]));
        }
      }
  } else {
    const int f0 = u.pn * 128 + wc * 32 + 8 * fq;
    const float* cw = p.ffn_conv_w + (size_t)layer * 3 * 2 * DFF + f0;
    const float* cbp = p.ffn_conv_b + (size_t)layer * 2 * DFF + f0;
#pragma unroll
    for (int q = 0; q < 2; ++q) {
      f32x4 wg[3], wv[3], bg, bv;
#pragma unroll
      for (int j = 0; j < 3; ++j) { wg[j] = *(const f32x4*)(cw + j * 2 * DFF + 4 * q); wv[j] = *(const f32x4*)(cw + j * 2 * DFF + DFF + 4 * q); }
      bg = *(const f32x4*)(cbp + 4 * q); bv = *(const f32x4*)(cbp + DFF + 4 * q);
#pragma unroll
      for (int ai = 0; ai < 2; ++ai) {
        int base, L, t0; halo_block(u.pm * 4 + ai * 2 + wr, base, L, t0);
#pragma unroll
        for (int m = 0; m < 4; ++m) {
          const int r = m * 16 + fr, t = t0 + r;
          const int mp = m > 0 ? m - 1 : 0, mn = m < 3 ? m + 1 : 3;
          f32x4 o;
#pragma unroll
          for (int j = 0; j < 4; ++j) {
            const float gc = acc[ai][0][m][q][j], vc = acc[ai][1][m][q][j];
            const float gp = dpp_ror1(fr == 15 ? acc[ai][0][mp][q][j] : gc), gn = dpp_ror15(fr == 0 ? acc[ai][0][mn][q][j] : gc);
            const float vp = dpp_ror1(fr == 15 ? acc[ai][1][mp][q][j] : vc), vn = dpp_ror15(fr == 0 ? acc[ai][1][mn][q][j] : vc);
            const float gg = wg[0][j] * gp + wg[1][j] * gc + wg[2][j] * gn + bg[j];
            const float vv = wv[0][j] * vp + wv[1][j] * vc + wv[2][j] * vn + bv[j];
            o[j] = gg * __builtin_amdgcn_rcpf(1.f + __expf(-gg)) * vv;
          }
          if (r >= 1 && r <= 62 && t < L)
            *(u32x2*)((char*)p.act + (unsigned)(((base + t) * DFF + f0 + 4 * q) * 2)) = mk2(pack2(o[0], o[1]), pack2(o[2], o[3]));
          __builtin_amdgcn_sched_barrier(0);
        }
      }
      __builtin_amdgcn_sched_barrier(0);
    }
  }
}

DI void attn_item(const Params& p, int layer, int item, char* smem) {
  constexpr int LDK = 136, LDV = 72;
  bf16_t* sK = (bf16_t*)smem;
  bf16_t* sV = sK + 64 * LDK;
  const int tid = tidx(), lane = tid & 63, wid = tid >> 6, l15 = lane & 15, quad = lane >> 4;
  bool isctx; int b, h, qb;
  if (item < 512) { b = item >> 6; h = (item >> 4) & 3; qb = item & 15; isctx = false; }
  else { int it = item - 512; b = it >> 3; h = (it >> 1) & 3; qb = it & 1; isctx = true; }
  const float lam_init = 0.8f - 0.6f * expf(-0.3f * (float)layer);
  float lam;
  {
    const float* lp = p.da_lambda + layer * 256;
    float a = lp[lane] * lp[64 + lane], c2 = lp[128 + lane] * lp[192 + lane];
    a = wave_sum(a); c2 = wave_sum(c2);
    lam = expf(a) - expf(c2) + lam_init;
  }
  const int qrow = (isctx ? NLAT + b * CTXL : b * SEQ) + qb * 128 + wid * 16 + l15;
  bf16x8 qf[2][2];
#pragma unroll
  for (int m = 0; m < 2; ++m)
#pragma unroll
    for (int kk = 0; kk < 2; ++kk) qf[m][kk] = *(const bf16x8*)(p.P + (size_t)qrow * PW + PC_Q + h * 128 + m * 64 + kk * 32 + quad * 8);
  const int ntile = isctx ? 4 : 36;
  const int k0_ = tid >> 4, kch = tid & 15;
  const int kpi0 = ((k0_ >> 2) & 1) * 16 + ((k0_ >> 3) & 3) * 4 + (k0_ & 3);
  const int kldsoff0 = kpi0 * LDK + kch * 8;
#define KLDS(i) (kldsoff0 + (i) * 32 * LDK)
  const long kgoff0 = (long)k0_ * PW + PC_K + h * 128 + kch * 8;
  const long kgstep = (long)32 * PW;
  const int dv0_ = tid >> 3, c8_ = tid & 7;
  const int vldsoff0 = dv0_ * LDV + c8_ * 8;
  const long vgoff0 = ((long)((b * 4 + h) * 128 + dv0_)) * NKEY + c8_ * 8;
  const long vgstep = (long)64 * NKEY;
  f32x4 oacc[2][8];
#pragma unroll
  for (int m = 0; m < 2; ++m)
#pragma unroll
    for (int t = 0; t < 8; ++t) oacc[m][t] = (f32x4){0.f, 0.f, 0.f, 0.f};
  float mrun0 = -1e30f, mrun1 = -1e30f, lsum0 = 0.f, lsum1 = 0.f;
  u32x4 rk[2], rv[2];
  {
    const bf16_t* kbase = p.P + (size_t)(NLAT + b * CTXL) * PW;
#pragma unroll
    for (int i = 0; i < 2; ++i) { rk[i] = *(const u32x4*)(kbase + kgoff0 + i * kgstep); rv[i] = *(const u32x4*)(p.Vt + vgoff0 + i * vgstep); }
  }
  constexpr int KBUF = 64 * LDK, VBUF = 128 * LDV;
  bf16_t* const sK0 = sK;
  bf16_t* const sV0 = sK + 2 * KBUF;
  const bool late = wid >= 4;
  bf16x8 pf[2][2];
#pragma unroll
  for (int m = 0; m < 2; ++m)
#pragma unroll
    for (int s_ = 0; s_ < 2; ++s_) pf[m][s_] = (bf16x8){0, 0, 0, 0, 0, 0, 0, 0};
  auto pv = [&](const bf16_t* sVx) {
#pragma unroll
    for (int s_ = 0; s_ < 2; ++s_)
#pragma unroll
      for (int t = 0; t < 8; ++t) {
        if ((t & 3) == 0) __builtin_amdgcn_sched_barrier(0);
        bf16x8 a = *(const bf16x8*)(sVx + (t * 16 + l15) * LDV + s_ * 32 + quad * 8);
        oacc[0][t] = __builtin_amdgcn_mfma_f32_16x16x32_bf16(a, pf[0][s_], oacc[0][t], 0, 0, 0);
        oacc[1][t] = __builtin_amdgcn_mfma_f32_16x16x32_bf16(a, pf[1][s_], oacc[1][t], 0, 0, 0);
      }
  };
  __syncthreads();
#pragma unroll
  for (int i = 0; i < 2; ++i) { *(u32x4*)(sK0 + KLDS(i)) = rk[i]; *(u32x4*)(sV0 + vldsoff0 + i * 64 * LDV) = rv[i]; }
  __syncthreads();
  for (int kt = 0; kt < ntile; ++kt) {
    sK = sK0 + (kt & 1) * KBUF;
    sV = sV0 + (kt % 3) * VBUF;
    if (kt + 1 < ntile) {
      int k2 = kt + 1;
      const bf16_t* kbase = (k2 < 4) ? p.P + (size_t)(NLAT + b * CTXL + k2 * 64) * PW : p.P + (size_t)(b * SEQ + (k2 - 4) * 64) * PW;
#pragma unroll
      for (int i = 0; i < 2; ++i) { rk[i] = *(const u32x4*)(kbase + kgoff0 + i * kgstep); rv[i] = *(const u32x4*)(p.Vt + vgoff0 + i * vgstep + k2 * 64); }
    }
    if (late && kt > 0) pv(sV0 + ((kt + 2) % 3) * VBUF);
    f32x4 sacc[2][4];
    __builtin_amdgcn_sched_barrier(0);
#pragma unroll
    for (int m = 0; m < 2; ++m)
#pragma unroll
      for (int tau = 0; tau < 4; ++tau) {
        f32x4 s = (f32x4){0.f, 0.f, 0.f, 0.f};
#pragma unroll
        for (int kk = 0; kk < 2; ++kk) {
          bf16x8 a = *(const bf16x8*)(sK + (tau * 16 + l15) * LDK + m * 64 + kk * 32 + quad * 8);
          s = __builtin_amdgcn_mfma_f32_16x16x32_bf16(a, qf[m][kk], s, 0, 0, 0);
        }
        sacc[m][tau] = s;
      }
    __builtin_amdgcn_sched_barrier(0);
#pragma unroll
    for (int m = 0; m < 2; ++m) {
      float mx = sacc[m][0][0];
#pragma unroll
      for (int tau = 0; tau < 4; ++tau)
#pragma unroll
        for (int j = 0; j < 4; ++j) mx = fmaxf(mx, sacc[m][tau][j]);
      {
        const auto r16 = __builtin_amdgcn_permlane16_swap(__float_as_uint(mx), __float_as_uint(mx), false, false);
        mx = fmaxf(__uint_as_float(r16[0]), __uint_as_float(r16[1]));
        const auto r32 = __builtin_amdgcn_permlane32_swap(__float_as_uint(mx), __float_as_uint(mx), false, false);
        mx = fmaxf(__uint_as_float(r32[0]), __uint_as_float(r32[1]));
      }
      const float mold = (m == 0) ? mrun0 : mrun1;
      const bool moved = __builtin_amdgcn_ballot_w64(mx > mold + 8.f) != 0ull;
      const float mnew = moved ? fmaxf(mold, mx) : mold;
      if (m == 0) mrun0 = mnew; else mrun1 = mnew;
      float ps = 0.f;
      u32x4 u0, u1;
      {
        float e0 = __builtin_amdgcn_exp2f(sacc[m][0][0] - mnew), e1 = __builtin_amdgcn_exp2f(sacc[m][0][1] - mnew), e2 = __builtin_amdgcn_exp2f(sacc[m][0][2] - mnew), e3 = __builtin_amdgcn_exp2f(sacc[m][0][3] - mnew);
        ps += (e0 + e1) + (e2 + e3); u0.x = pack2(e0, e1); u0.y = pack2(e2, e3);
      }
      {
        float e0 = __builtin_amdgcn_exp2f(sacc[m][1][0] - mnew), e1 = __builtin_amdgcn_exp2f(sacc[m][1][1] - mnew), e2 = __builtin_amdgcn_exp2f(sacc[m][1][2] - mnew), e3 = __builtin_amdgcn_exp2f(sacc[m][1][3] - mnew);
        ps += (e0 + e1) + (e2 + e3); u0.z = pack2(e0, e1); u0.w = pack2(e2, e3);
      }
      {
        float e0 = __builtin_amdgcn_exp2f(sacc[m][2][0] - mnew), e1 = __builtin_amdgcn_exp2f(sacc[m][2][1] - mnew), e2 = __builtin_amdgcn_exp2f(sacc[m][2][2] - mnew), e3 = __builtin_amdgcn_exp2f(sacc[m][2][3] - mnew);
        ps += (e0 + e1) + (e2 + e3); u1.x = pack2(e0, e1); u1.y = pack2(e2, e3);
      }
      {
        float e0 = __builtin_amdgcn_exp2f(sacc[m][3][0] - mnew), e1 = __builtin_amdgcn_exp2f(sacc[m][3][1] - mnew), e2 = __builtin_amdgcn_exp2f(sacc[m][3][2] - mnew), e3 = __builtin_amdgcn_exp2f(sacc[m][3][3] - mnew);
        ps += (e0 + e1) + (e2 + e3); u1.z = pack2(e0, e1); u1.w = pack2(e2, e3);
      }
      if (moved) {
        const float alpha = __builtin_amdgcn_exp2f(mold - mnew);
        if (m == 0) lsum0 *= alpha; else lsum1 *= alpha;
#pragma unroll
        for (int t = 0; t < 8; ++t) { oacc[m][t][0] *= alpha; oacc[m][t][1] *= alpha; oacc[m][t][2] *= alpha; oacc[m][t][3] *= alpha; }
      }
      if (m == 0) lsum0 += ps; else lsum1 += ps;
      pf[m][0] = __builtin_bit_cast(bf16x8, u0);
      pf[m][1] = __builtin_bit_cast(bf16x8, u1);
    }
    __builtin_amdgcn_sched_barrier(0);
    if (!late) pv(sV);
    if (kt + 1 < ntile) {
      bf16_t* nK = sK0 + ((kt + 1) & 1) * KBUF;
      bf16_t* nV = sV0 + ((kt + 1) % 3) * VBUF;
#pragma unroll
      for (int i = 0; i < 2; ++i) { *(u32x4*)(nK + KLDS(i)) = rk[i]; *(u32x4*)(nV + vldsoff0 + i * 64 * LDV) = rv[i]; }
    }
    __syncthreads();
  }
  if (late) pv(sV0 + ((ntile - 1) % 3) * VBUF);
  float l0 = lsum0, l1 = lsum1;
  l0 += __shfl_xor(l0, 16); l0 += __shfl_xor(l0, 32);
  l1 += __shfl_xor(l1, 16); l1 += __shfl_xor(l1, 32);
  const float i0 = 1.f / l0, i1 = lam / l1;
  float ss = 0.f;
#pragma unroll
  for (int t = 0; t < 8; ++t)
#pragma unroll
    for (int j = 0; j < 4; ++j) {
      float o = oacc[0][t][j] * i0 - oacc[1][t][j] * i1;
      oacc[0][t][j] = o;
      ss += o * o;
    }
  ss += __shfl_xor(ss, 16); ss += __shfl_xor(ss, 32);
  const float rstd = rsqrtf(ss * (1.f / 128.f) + 1e-6f) * (1.f - lam_init);
  const float* sg = p.da_subln_g + layer * 128;
#pragma unroll
  for (int t = 0; t < 8; ++t) {
    int dv = t * 16 + quad * 4;
    float4 g = *(const float4*)(sg + dv);
    *(u32x2*)(p.Abuf + (size_t)qrow * D + h * 128 + dv) =
        mk2(pack2(oacc[0][t][0] * rstd * g.x, oacc[0][t][1] * rstd * g.y), pack2(oacc[0][t][2] * rstd * g.z, oacc[0][t][3] * rstd * g.w));
  }
}

DI float red16(float v) {
  v += __int_as_float(__builtin_amdgcn_update_dpp(0, __float_as_int(v), 0xB1, 0xF, 0xF, true));
  v += __int_as_float(__builtin_amdgcn_update_dpp(0, __float_as_int(v), 0x4E, 0xF, 0xF, true));
  v += __int_as_float(__builtin_amdgcn_update_dpp(0, __float_as_int(v), 0x141, 0xF, 0xF, true));
  v += __int_as_float(__builtin_amdgcn_update_dpp(0, __float_as_int(v), 0x140, 0xF, 0xF, true));
  return v;
}
DI float red8(float v) {
  v += __int_as_float(__builtin_amdgcn_update_dpp(0, __float_as_int(v), 0xB1, 0xF, 0xF, true));
  v += __int_as_float(__builtin_amdgcn_update_dpp(0, __float_as_int(v), 0x4E, 0xF, 0xF, true));
  v += __int_as_float(__builtin_amdgcn_update_dpp(0, __float_as_int(v), 0x141, 0xF, 0xF, true));
  return v;
}
constexpr int SC2_Q = 0, SC2_K = 2048, SC2_V = 4096, SC2_A = 6144, SC2_O = 6272, SC2_BUF = 8320;
template <int MX>
DI void scan_item(const Params& p, int layer, int dir, int b, int h, float* sm) {
  const int tfull = tidx();
  const bool stager = tfull >= 256;
  const int tid = tfull & 255;
  const int e = tid >> 2, part = tid & 3;
  const int pl = tid >> 3, p8 = tid & 7;
  const int slot_w = dir == 0 ? pl : 31 - pl;
  f32x2 s2[8];
#pragma unroll
  for (int d = 0; d < 8; ++d) s2[d] = (f32x2){0.f, 0.f};
  float lbf[8], oml[8];
  float gA = 0.f, gdt = 0.f;
  if (MX == 0) {
#pragma unroll
    for (int d = 0; d < 8; ++d) {
      float lb = 0.f;
      if (layer == 1) {
        int ci = dir * 256 + h * 64 + p8 * 8 + d;
        float l0 = p.hg_lb_logits[ci], l1 = p.hg_lb_logits[512 + ci];
        lb = 1.f / (1.f + expf(l0 - l1));
      }
      lbf[d] = fmaxf(lb, 1e-30f);
      oml[d] = 1.f - lb;
    }
  } else {
    gA = expf(p.gd_a_log[layer * 8 + dir * 4 + h]);
    gdt = p.gd_dt_bias[layer * 8 + dir * 4 + h];
  }
  const float* cw = p.gd_conv_w + (size_t)layer * 3 * 768;
  u32x4 rq[3], rk[3], rv[3];
  float ra_ = 0.f, rb_ = 0.f;
  const u32x4 z4 = {0u, 0u, 0u, 0u};
#pragma unroll
  for (int j = 0; j < 3; ++j) { rq[j] = z4; rk[j] = z4; rv[j] = z4; }

#define SCAN_CHUNK_GEOM(c)                                                   \
  const int seg_ = (c) < 8 ? 0 : 1;                                          \
  const int L_ = seg_ == 0 ? CTXL : SEQ;                                     \
  const int rowbase_ = seg_ == 0 ? NLAT + b * CTXL : b * SEQ;                \
  const int ci_ = seg_ == 0 ? (c) : (c) - 8;                                 \
  const int p0_ = dir == 0 ? ci_ * 32 : L_ - 32 * (ci_ + 1);

  auto load_raw = [&](int c) {
    SCAN_CHUNK_GEOM(c)
    const int pos = p0_ + pl;
    const bf16_t* prow = p.P + (size_t)(rowbase_ + pos) * PW;
    if (MX == 0) {
      rq[0] = *(const u32x4*)(prow + PC_HQ + h * 64 + p8 * 8);
      rk[0] = *(const u32x4*)(prow + PC_HF + dir * 256 + h * 64 + p8 * 8);
      rv[0] = *(const u32x4*)(prow + PC_HI + h * 64 + p8 * 8);
    } else {
#pragma unroll
      for (int j = 0; j < 3; ++j) {
        const int pp = pos + j - 1;
        const bool ok = (pp >= 0 && pp < L_);
        const bf16_t* pr = p.P + (size_t)(rowbase_ + pp) * PW + PC_GQKV + h * 64 + p8 * 8;
        rq[j] = ok ? *(const u32x4*)(pr) : z4;
        rk[j] = ok ? *(const u32x4*)(pr + 256) : z4;
        rv[j] = ok ? *(const u32x4*)(pr + 512) : z4;
      }
      if (p8 == 0) { ra_ = bf2f(prow[PC_GA + dir * 4 + h]); rb_ = bf2f(prow[PC_GB + dir * 4 + h]); }
    }
  };
  auto compute_store = [&](float* buf) {
    float* sq = buf + SC2_Q + slot_w * 64 + p8 * 8;
    float* sk = buf + SC2_K + slot_w * 64 + p8 * 8;
    float* sv = buf + SC2_V + slot_w * 64 + p8 * 8;
    if (MX == 0) {
      float qv[8], fv[8], iv[8];
      unpack8(rq[0], qv); unpack8(rk[0], fv); unpack8(rv[0], iv);
      f32x4 o0, o1, f0, f1;
#pragma unroll
      for (int d = 0; d < 4; ++d) {
        o0[d] = qv[d] * __builtin_amdgcn_rcpf(1.f + __expf(-qv[d])); o1[d] = qv[4 + d] * __builtin_amdgcn_rcpf(1.f + __expf(-qv[4 + d]));
        f0[d] = lbf[d] + oml[d] * __builtin_amdgcn_rcpf(1.f + __expf(-fv[d])); f1[d] = lbf[4 + d] + oml[4 + d] * __builtin_amdgcn_rcpf(1.f + __expf(-fv[4 + d]));
      }
      *(f32x4*)(sq) = o0; *(f32x4*)(sq + 4) = o1;
      *(f32x4*)(sk) = f0; *(f32x4*)(sk + 4) = f1;
      const f32x4 v0 = {iv[0], iv[1], iv[2], iv[3]}, v1 = {iv[4], iv[5], iv[6], iv[7]};
      *(f32x4*)(sv) = v0; *(f32x4*)(sv + 4) = v1;
    } else {
      float yq[8], yk[8], yv[8];
#pragma unroll
      for (int d = 0; d < 8; ++d) { yq[d] = 0.f; yk[d] = 0.f; yv[d] = 0.f; }
#pragma unroll
      for (int j = 0; j < 3; ++j) {
        float xq[8], xk[8], xv[8];
        unpack8(rq[j], xq); unpack8(rk[j], xk); unpack8(rv[j], xv);
        const float* cq = cw + j * 768 + h * 64 + p8 * 8;
        const f32x4 wq0 = *(const f32x4*)(cq), wq1 = *(const f32x4*)(cq + 4);
        const f32x4 wk0 = *(const f32x4*)(cq + 256), wk1 = *(const f32x4*)(cq + 260);
        const f32x4 wv0 = *(const f32x4*)(cq + 512), wv1 = *(const f32x4*)(cq + 516);
#pragma unroll
        for (int d = 0; d < 4; ++d) {
          yq[d] += xq[d] * wq0[d]; yq[4 + d] += xq[4 + d] * wq1[d];
          yk[d] += xk[d] * wk0[d]; yk[4 + d] += xk[4 + d] * wk1[d];
          yv[d] += xv[d] * wv0[d]; yv[4 + d] += xv[4 + d] * wv1[d];
        }
      }
      float sq2 = 0.f, sk2 = 0.f;
#pragma unroll
      for (int d = 0; d < 8; ++d) {
        yq[d] = yq[d] * __builtin_amdgcn_rcpf(1.f + __expf(-yq[d]));
        yk[d] = yk[d] * __builtin_amdgcn_rcpf(1.f + __expf(-yk[d]));
        yv[d] = yv[d] * __builtin_amdgcn_rcpf(1.f + __expf(-yv[d]));
        sq2 += yq[d] * yq[d]; sk2 += yk[d] * yk[d];
      }
      sq2 = red8(sq2); sk2 = red8(sk2);
      const float rqn = rsqrtf(sq2 + 1e-6f) * 0.125f, rkn = rsqrtf(sk2 + 1e-6f);
      float qk = 0.f;
      f32x4 o0, o1, k0, k1;
#pragma unroll
      for (int d = 0; d < 4; ++d) {
        o0[d] = yq[d] * rqn; o1[d] = yq[4 + d] * rqn; k0[d] = yk[d] * rkn; k1[d] = yk[4 + d] * rkn;
        qk += o0[d] * k0[d] + o1[d] * k1[d];
      }
      qk = red8(qk);
      *(f32x4*)(sq) = o0; *(f32x4*)(sq + 4) = o1;
      *(f32x4*)(sk) = k0; *(f32x4*)(sk + 4) = k1;
      const f32x4 v0 = {yv[0], yv[1], yv[2], yv[3]}, v1 = {yv[4], yv[5], yv[6], yv[7]};
      *(f32x4*)(sv) = v0; *(f32x4*)(sv + 4) = v1;
      if (p8 == 0) {
        const float xx = ra_ + gdt;
        const float y = __expf(xx);
        const float sp = xx > 15.f ? xx : (y < 1e-3f ? y * (1.f - 0.5f * y) : __logf(1.f + y));
        const f32x4 rec = {__expf(-gA * sp), __builtin_amdgcn_rcpf(1.f + __expf(-rb_)), qk, 0.f};
        *(f32x4*)(buf + SC2_A + slot_w * 4) = rec;
      }
    }
  };
  auto write_out = [&](int c) {
    SCAN_CHUNK_GEOM(c)
    const float* so = sm + (c & 1) * SC2_BUF + SC2_O + slot_w * 64 + p8 * 8;
    const f32x4 a0 = *(const f32x4*)so, a1 = *(const f32x4*)(so + 4);
    bf16_t* dst = p.raw + ((size_t)((MX * 2 + dir) * NROW + rowbase_ + p0_ + pl)) * 256 + h * 64 + p8 * 8;
    *(u32x4*)dst = mk4(pack2(a0[0], a0[1]), pack2(a0[2], a0[3]), pack2(a1[0], a1[1]), pack2(a1[2], a1[3]));
  };

  constexpr int NCH = 8 + 64;
  __syncthreads();
  if (stager) { load_raw(0); compute_store(sm); }
  __syncthreads();
  if (!stager) __builtin_amdgcn_s_setprio(3);
  for (int c = 0; c < NCH; ++c) {
    if (stager) {
      if (c + 1 < NCH) load_raw(c + 1);
      if (c > 0) write_out(c - 1);
      if (c + 1 < NCH) compute_store(sm + ((c + 1) & 1) * SC2_BUF);
    } else {
      const float* buf = sm + (c & 1) * SC2_BUF;
      const float* sq = buf + SC2_Q + part * 16;
      const float* sk = buf + SC2_K + part * 16;
      const float* sv = buf + SC2_V + e;
      const float* sa = buf + SC2_A;
      float* so = sm + (c & 1) * SC2_BUF + SC2_O + e;
      f32x4 qn[4], kn[4];
      float vnx;
      f32x4 recn = {0.f, 0.f, 0.f, 0.f};
#pragma unroll
      for (int u = 0; u < 4; ++u) { qn[u] = *(const f32x4*)(sq + 4 * u); kn[u] = *(const f32x4*)(sk + 4 * u); }
      vnx = sv[0];
      if (MX == 1) recn = *(const f32x4*)(sa);
#pragma unroll
      for (int i = 0; i < 32; ++i) {
        f32x4 q[4], k[4];
#pragma unroll
        for (int u = 0; u < 4; ++u) { q[u] = qn[u]; k[u] = kn[u]; }
        const float vv = vnx;
        const f32x4 rec = recn;
        const int il = (i < 31) ? i + 1 : i;
#pragma unroll
        for (int u = 0; u < 4; ++u) { qn[u] = *(const f32x4*)(sq + il * 64 + 4 * u); kn[u] = *(const f32x4*)(sk + il * 64 + 4 * u); }
        vnx = sv[il * 64];
        if (MX == 1) recn = *(const f32x4*)(sa + il * 4);
        float o;
        if (MX == 0) {
          const f32x2 vv2 = {vv, vv};
          f32x2 acc2 = {0.f, 0.f};
#pragma unroll
          for (int u = 0; u < 4; ++u) {
            const f32x2 klo = {k[u][0], k[u][1]}, khi = {k[u][2], k[u][3]};
            const f32x2 qlo = {q[u][0], q[u][1]}, qhi = {q[u][2], q[u][3]};
            s2[2 * u] = vv2 + klo * (s2[2 * u] - vv2);
            s2[2 * u + 1] = vv2 + khi * (s2[2 * u + 1] - vv2);
            acc2 += s2[2 * u] * qlo;
            acc2 += s2[2 * u + 1] * qhi;
          }
          o = quad_sum(acc2[0] + acc2[1]);
        } else {
          const float al = rec[0], be = rec[1], qk = rec[2];
          f32x2 ks2 = {0.f, 0.f}, qs2 = {0.f, 0.f};
#pragma unroll
          for (int u = 0; u < 4; ++u) {
            const f32x2 klo = {k[u][0], k[u][1]}, khi = {k[u][2], k[u][3]};
            const f32x2 qlo = {q[u][0], q[u][1]}, qhi = {q[u][2], q[u][3]};
            ks2 += klo * s2[2 * u]; ks2 += khi * s2[2 * u + 1];
            qs2 += qlo * s2[2 * u]; qs2 += qhi * s2[2 * u + 1];
          }
          const float ks = quad_sum(ks2[0] + ks2[1]), qs = quad_sum(qs2[0] + qs2[1]);
          const float vn = be * (vv - al * ks);
          const f32x2 al2 = {al, al}, vn2 = {vn, vn};
#pragma unroll
          for (int u = 0; u < 4; ++u) {
            const f32x2 klo = {k[u][0], k[u][1]}, khi = {k[u][2], k[u][3]};
            s2[2 * u] = al2 * s2[2 * u] + klo * vn2;
            s2[2 * u + 1] = al2 * s2[2 * u + 1] + khi * vn2;
          }
          o = al * qs + qk * vn;
        }
        so[i * 64] = o;
      }
    }
    __syncthreads();
  }
  __builtin_amdgcn_s_setprio(0);
  if (stager) write_out(NCH - 1);
}

constexpr int GD_QK = 4272;
constexpr int GD_V = 3 * GD_QK;
constexpr int GD_VNT = GD_V + 2 * 2048;
constexpr int GD_S0 = GD_VNT + 2 * 2048;
constexpr int GD_GC = GD_S0 + 2 * 2048;
constexpr int GD_QKB = GD_GC + 128;
DI bf16x8 cvt8(const f32x4 a, const f32x4 b) {
  const u32x4 u = mk4(pack2(a[0], a[1]), pack2(a[2], a[3]), pack2(b[0], b[1]), pack2(b[2], b[3]));
  return __builtin_bit_cast(bf16x8, u);
}
DI void scan_item_gdn(const Params& p, int layer, int dir, int b, int h, float* sm) {
  const int tfull = tidx();
  const bool stager = tfull >= 256;
  const int tid = tfull & 255;
  const int e = tid >> 2, part = tid & 3;
  const int pl = tid >> 3, p8 = tid & 7;
  const int slot_w = dir == 0 ? pl : 31 - pl;
  const int sw = tid >> 6, lane = tid & 63, l15 = lane & 15, g = lane >> 4;
  f32x2 s2[8];
#pragma unroll
  for (int d = 0; d < 8; ++d) s2[d] = (f32x2){0.f, 0.f};
  const float gA = expf(p.gd_a_log[layer * 8 + dir * 4 + h]);
  const float gdt = p.gd_dt_bias[layer * 8 + dir * 4 + h];
  const float* cw = p.gd_conv_w + (size_t)layer * 3 * 768;
  u32x4 rq[3], rk[3], rv[3];
  float ra_ = 0.f, rb_ = 0.f;
  const u32x4 z4 = {0u, 0u, 0u, 0u};
#pragma unroll
  for (int j = 0; j < 3; ++j) { rq[j] = z4; rk[j] = z4; rv[j] = z4; }

#define GDN_CHUNK_GEOM(c)                                                    \
  const int seg_ = (c) < 8 ? 0 : 1;                                          \
  const int L_ = seg_ == 0 ? CTXL : SEQ;                                     \
  const int rowbase_ = seg_ == 0 ? NLAT + b * CTXL : b * SEQ;                \
  const int ci_ = seg_ == 0 ? (c) : (c) - 8;                                 \
  const int p0_ = dir == 0 ? ci_ * 32 : L_ - 32 * (ci_ + 1);

  auto load_raw = [&](int c) {
    GDN_CHUNK_GEOM(c)
    const int pos = p0_ + pl;
    const bf16_t* prow = p.P + (size_t)(rowbase_ + pos) * PW;
#pragma unroll
    for (int j = 0; j < 3; ++j) {
      const int pp = pos + j - 1;
      const bool ok = (pp >= 0 && pp < L_);
      const bf16_t* pr = p.P + (size_t)(rowbase_ + pp) * PW + PC_GQKV + h * 64 + p8 * 8;
      rq[j] = ok ? *(const u32x4*)(pr) : z4;
      rk[j] = ok ? *(const u32x4*)(pr + 256) : z4;
      rv[j] = ok ? *(const u32x4*)(pr + 512) : z4;
    }
    if (sw == 0 && lane < 32) {
      const int pos2 = p0_ + (dir == 0 ? lane : 31 - lane);
      const bf16_t* pr2 = p.P + (size_t)(rowbase_ + pos2) * PW;
      ra_ = bf2f(pr2[PC_GA + dir * 4 + h]); rb_ = bf2f(pr2[PC_GB + dir * 4 + h]);
    }
  };
  auto compute_store = [&](int c) {
    float* qk = sm + (c % 3) * GD_QK;
    float* sq = qk + slot_w * 64 + p8 * 8;
    float* sk = qk + 2048 + slot_w * 64 + p8 * 8;
    float* sv = sm + GD_V + (c & 1) * 2048 + slot_w * 64 + p8 * 8;
    float yq[8], yk[8], yv[8];
#pragma unroll
    for (int d = 0; d < 8; ++d) { yq[d] = 0.f; yk[d] = 0.f; yv[d] = 0.f; }
#pragma unroll
    for (int j = 0; j < 3; ++j) {
      float xq[8], xk[8], xv[8];
      unpack8(rq[j], xq); unpack8(rk[j], xk); unpack8(rv[j], xv);
      const float* cq = cw + j * 768 + h * 64 + p8 * 8;
      const f32x4 wq0 = *(const f32x4*)(cq), wq1 = *(const f32x4*)(cq + 4);
      const f32x4 wk0 = *(const f32x4*)(cq + 256), wk1 = *(const f32x4*)(cq + 260);
      const f32x4 wv0 = *(const f32x4*)(cq + 512), wv1 = *(const f32x4*)(cq + 516);
#pragma unroll
      for (int d = 0; d < 4; ++d) {
        yq[d] += xq[d] * wq0[d]; yq[4 + d] += xq[4 + d] * wq1[d];
        yk[d] += xk[d] * wk0[d]; yk[4 + d] += xk[4 + d] * wk1[d];
        yv[d] += xv[d] * wv0[d]; yv[4 + d] += xv[4 + d] * wv1[d];
      }
    }
    float sq2 = 0.f, sk2 = 0.f;
#pragma unroll
    for (int d = 0; d < 8; ++d) {
      yq[d] = yq[d] * __builtin_amdgcn_rcpf(1.f + __expf(-yq[d]));
      yk[d] = yk[d] * __builtin_amdgcn_rcpf(1.f + __expf(-yk[d]));
      yv[d] = yv[d] * __builtin_amdgcn_rcpf(1.f + __expf(-yv[d]));
      sq2 += yq[d] * yq[d]; sk2 += yk[d] * yk[d];
    }
    sq2 = red8(sq2); sk2 = red8(sk2);
    const float rqn = rsqrtf(sq2 + 1e-6f) * 0.125f, rkn = rsqrtf(sk2 + 1e-6f);
    f32x4 o0, o1, k0, k1;
#pragma unroll
    for (int d = 0; d < 4; ++d) { o0[d] = yq[d] * rqn; o1[d] = yq[4 + d] * rqn; k0[d] = yk[d] * rkn; k1[d] = yk[4 + d] * rkn; }
    *(f32x4*)(sq) = o0; *(f32x4*)(sq + 4) = o1;
    *(f32x4*)(sk) = k0; *(f32x4*)(sk + 4) = k1;
    {
      bf16_t* qkb = (bf16_t*)(sm + GD_QKB + (c % 3) * 2048);
      *(bf16x8*)(qkb + slot_w * 64 + p8 * 8) = cvt8(o0, o1);
      *(bf16x8*)(qkb + 2048 + slot_w * 64 + p8 * 8) = cvt8(k0, k1);
    }
    const f32x4 v0 = {yv[0], yv[1], yv[2], yv[3]}, v1 = {yv[4], yv[5], yv[6], yv[7]};
    *(f32x4*)(sv) = v0; *(f32x4*)(sv + 4) = v1;
    if (sw == 0) {
      const float xx = ra_ + gdt;
      const float y = __expf(xx);
      const float sp = xx > 15.f ? xx : (y < 1e-3f ? y * (1.f - 0.5f * y) : __logf(1.f + y));
      const float la = fmaxf(-gA * sp * 1.4426950408889634f, -30.f);
      const float be = __builtin_amdgcn_rcpf(1.f + __expf(-rb_));
      float L = (lane < 32) ? la : 0.f;
#pragma unroll
      for (int off = 1; off < 32; off <<= 1) { const float t = __shfl_up(L, off); if (lane >= off) L += t; }
      float B = __shfl(L, (lane & ~3) - 1);
      if (lane < 4) B = 0.f;
      const float cc = __builtin_amdgcn_exp2f(L - B), inv = __builtin_amdgcn_exp2f(B - L);
      if (lane < 32) {
        const f32x4 rec = {cc, be, inv, 0.f};
        *(f32x4*)(qk + 4096 + lane * 4) = rec;
        qk[4224 + lane] = la;
      }
    }
  };
  auto output = [&](int c) {
    GDN_CHUNK_GEOM(c)
    const float* qk = sm + (c % 3) * GD_QK;
    const float* sq = qk;
    const float* sk = qk + 2048;
    const float* rec = qk + 4096;
    const float* vnt = sm + GD_VNT + (c & 1) * 2048;
    const bf16_t* s0t = (const bf16_t*)(sm + GD_S0 + (c & 1) * 2048);
    float* gcs = sm + GD_GC + sw * 32;
    {
      float x = (lane < 32) ? qk[4224 + lane] : 0.f;
#pragma unroll
      for (int off = 1; off < 32; off <<= 1) { const float t = __shfl_up(x, off); if (lane >= off) x += t; }
      if (lane < 32) gcs[lane] = x;
    }
    const float gct0 = gcs[l15], gct1 = gcs[16 + l15];
    const float eg0 = __builtin_amdgcn_exp2f(gct0), eg1 = __builtin_amdgcn_exp2f(gct1);
    const bf16_t* qb = (const bf16_t*)(sm + GD_QKB + (c % 3) * 2048);
    const bf16_t* kb = qb + 2048;
    bf16x8 qf[2][2];
#pragma unroll
    for (int n = 0; n < 2; ++n)
#pragma unroll
      for (int kk = 0; kk < 2; ++kk) qf[n][kk] = *(const bf16x8*)(qb + (16 * n + l15) * 64 + 32 * kk + 8 * g);
    f32x4 acc[2];
#pragma unroll
    for (int n = 0; n < 2; ++n) acc[n] = (f32x4){0.f, 0.f, 0.f, 0.f};
#pragma unroll
    for (int kk = 0; kk < 2; ++kk) {
      const bf16x8 a = *(const bf16x8*)(s0t + (16 * sw + l15) * 64 + 32 * kk + 8 * g);
      acc[0] = __builtin_amdgcn_mfma_f32_16x16x32_bf16(a, qf[0][kk], acc[0], 0, 0, 0);
      acc[1] = __builtin_amdgcn_mfma_f32_16x16x32_bf16(a, qf[1][kk], acc[1], 0, 0, 0);
    }
    acc[0] *= eg0; acc[1] *= eg1;
    f32x4 wt[2][2];
#pragma unroll
    for (int m = 0; m < 2; ++m)
#pragma unroll
      for (int n = 0; n < 2; ++n) wt[m][n] = (f32x4){0.f, 0.f, 0.f, 0.f};
#pragma unroll
    for (int m = 0; m < 2; ++m)
#pragma unroll
      for (int kk = 0; kk < 2; ++kk) {
        const bf16x8 a = *(const bf16x8*)(kb + (16 * m + l15) * 64 + 32 * kk + 8 * g);
        if (m == 0) wt[0][0] = __builtin_amdgcn_mfma_f32_16x16x32_bf16(a, qf[0][kk], wt[0][0], 0, 0, 0);
        wt[m][1] = __builtin_amdgcn_mfma_f32_16x16x32_bf16(a, qf[1][kk], wt[m][1], 0, 0, 0);
      }
#pragma unroll
    for (int m = 0; m < 2; ++m) {
      const f32x4 gs = *(const f32x4*)(gcs + 16 * m + 4 * g);
#pragma unroll
      for (int n = 0; n < 2; ++n) {
        if (m == 1 && n == 0) continue;
        const float gt = n == 0 ? gct0 : gct1;
        const int t = 16 * n + l15;
#pragma unroll
        for (int j = 0; j < 4; ++j) {
          const int s_ = 16 * m + 4 * g + j;
          wt[m][n][j] = (s_ <= t) ? wt[m][n][j] * __builtin_amdgcn_exp2f(gt - gs[j]) : 0.f;
        }
      }
    }
    {
      const float* vsrc = vnt + (16 * sw + l15) * 32 + 4 * g;
      const bf16x8 a = cvt8(*(const f32x4*)vsrc, *(const f32x4*)(vsrc + 16));
#pragma unroll
      for (int n = 0; n < 2; ++n) {
        const bf16x8 bw = cvt8(wt[0][n], wt[1][n]);
        acc[n] = __builtin_amdgcn_mfma_f32_16x16x32_bf16(a, bw, acc[n], 0, 0, 0);
      }
    }
#pragma unroll
    for (int n = 0; n < 2; ++n) {
      const int t = 16 * n + l15;
      const int pos = p0_ + (dir == 0 ? t : 31 - t);
      bf16_t* dst = p.raw + ((size_t)((1 * 2 + dir) * NROW + rowbase_ + pos)) * 256 + h * 64 + 16 * sw + 4 * g;
      *(u32x2*)dst = mk2(pack2(acc[n][0], acc[n][1]), pack2(acc[n][2], acc[n][3]));
    }
  };

  constexpr int NCH = 8 + 64;
  __syncthreads();
  if (stager) { load_raw(0); compute_store(0); }
  __syncthreads();
  if (!stager) __builtin_amdgcn_s_setprio(3);
  for (int c = 0; c < NCH; ++c) {
    if (stager) {
      if (c + 1 < NCH) load_raw(c + 1);
      if (c > 0) output(c - 1);
      if (c + 1 < NCH) compute_store(c + 1);
    } else {
      const float* qk = sm + (c % 3) * GD_QK;
      const float* sq = qk + part * 16;
      const float* sk = qk + 2048 + part * 16;
      const float* sa = qk + 4096;
      const float* sv = sm + GD_V + (c & 1) * 2048 + e;
      float* vnt = sm + GD_VNT + (c & 1) * 2048 + e * 32;
      {
        bf16_t* s0 = (bf16_t*)(sm + GD_S0 + (c & 1) * 2048) + e * 64 + part * 16;
        *(u32x4*)s0 = mk4(pack2(s2[0][0], s2[0][1]), pack2(s2[1][0], s2[1][1]), pack2(s2[2][0], s2[2][1]), pack2(s2[3][0], s2[3][1]));
        *(u32x4*)(s0 + 8) = mk4(pack2(s2[4][0], s2[4][1]), pack2(s2[5][0], s2[5][1]), pack2(s2[6][0], s2[6][1]), pack2(s2[7][0], s2[7][1]));
      }
      f32x4 kn[4];
      float vnx;
      f32x4 recn;
#pragma unroll
      for (int u = 0; u < 4; ++u) kn[u] = *(const f32x4*)(sk + 4 * u);
      vnx = sv[0];
      recn = *(const f32x4*)(sa);
#pragma unroll
      for (int i = 0; i < 32; ++i) {
        f32x4 k[4];
#pragma unroll
        for (int u = 0; u < 4; ++u) k[u] = kn[u];
        const float vv = vnx;
        const f32x4 rec = recn;
        const int il = (i < 31) ? i + 1 : i;
#pragma unroll
        for (int u = 0; u < 4; ++u) kn[u] = *(const f32x4*)(sk + il * 64 + 4 * u);
        vnx = sv[il * 64];
        recn = *(const f32x4*)(sa + il * 4);
        const float cc = rec[0], be = rec[1], inv = rec[2];
        f32x2 ks2 = {0.f, 0.f};
#pragma unroll
        for (int u = 0; u < 4; ++u) {
          const f32x2 klo = {k[u][0], k[u][1]}, khi = {k[u][2], k[u][3]};
          ks2 += klo * s2[2 * u]; ks2 += khi * s2[2 * u + 1];
        }
        const float dd = quad_sum(ks2[0] + ks2[1]);
        const float w = be * (vv * inv - dd);
        const float vn = w * cc;
        const f32x2 w2 = {w, w};
#pragma unroll
        for (int u = 0; u < 4; ++u) {
          const f32x2 klo = {k[u][0], k[u][1]}, khi = {k[u][2], k[u][3]};
          s2[2 * u] += klo * w2;
          s2[2 * u + 1] += khi * w2;
        }
        if ((i & 3) == 3) {
          const f32x2 cc2 = {cc, cc};
#pragma unroll
          for (int u = 0; u < 8; ++u) s2[u] *= cc2;
        }
        vnt[i] = vn;
      }
      (void)sq;
    }
    __syncthreads();
  }
  __builtin_amdgcn_s_setprio(0);
  if (stager) output(NCH - 1);
}

DI void finish_phase(const Params& p, int layer) {
  const int lane = tidx() & 63, wid = tidx() >> 6;
  const int nrows = (layer == 1) ? NLAT : NROW;
  for (int idx = bidx() * NWAVE + wid; idx < nrows * 2; idx += gridDim.x * NWAVE) {
    const int row = idx >> 1, mx = idx & 1;
    u32x2 uf = __builtin_nontemporal_load((const u32x2*)(p.raw + ((size_t)((mx * 2 + 0) * NROW + row)) * 256 + lane * 4));
    u32x2 ub = __builtin_nontemporal_load((const u32x2*)(p.raw + ((size_t)((mx * 2 + 1) * NROW + row)) * 256 + lane * 4));
    float o[4];
    o[0] = __uint_as_float(uf.x << 16) + __uint_as_float(ub.x << 16);
    o[1] = __uint_as_float(uf.x & 0xffff0000u) + __uint_as_float(ub.x & 0xffff0000u);
    o[2] = __uint_as_float(uf.y << 16) + __uint_as_float(ub.y << 16);
    o[3] = __uint_as_float(uf.y & 0xffff0000u) + __uint_as_float(ub.y & 0xffff0000u);
    float ss = o[0] * o[0] + o[1] * o[1] + o[2] * o[2] + o[3] * o[3];
    ss += __shfl_xor(ss, 1); ss += __shfl_xor(ss, 2); ss += __shfl_xor(ss, 4); ss += __shfl_xor(ss, 8);
    const float rstd = rsqrtf(ss * (1.f / 64.f) + 1e-6f);
    u32x2 ug = *(const u32x2*)(p.P + (size_t)row * PW + (mx == 0 ? PC_HG : PC_GG) + lane * 4);
    float g[4] = {__uint_as_float(ug.x << 16), __uint_as_float(ug.x & 0xffff0000u), __uint_as_float(ug.y << 16), __uint_as_float(ug.y & 0xffff0000u)};
    const float* ng = (mx == 0 ? p.hg_norm_g : p.gd_norm_g) + layer * 64 + (lane & 15) * 4;
    float r[4];
#pragma unroll
    for (int j = 0; j < 4; ++j) r[j] = (o[j] * rstd * ng[j]) * silu_f(g[j]);
    *(u32x2*)(p.Abuf + (size_t)row * D + 512 + mx * 256 + lane * 4) = mk2(pack2(r[0], r[1]), pack2(r[2], r[3]));
  }
}

DI void run_phase(const Params& p, int ph, char* smem) {
  const int bid = bidx(), G = gridDim.x;
  LAS unsigned char* lds = (LAS unsigned char*)smem;
  if (ph == 0) {
    for (int pr = bid; pr < (WT_IN + 1) / 2; pr += G) weight_pair(p, 0, 0, WT_IN, pr, smem);
    for (int it = bid; it < 192; it += G) mod_item(p, it, (float*)smem);
    for (int it = bid; it < 64; it += G) rope_item(p, it);
    if (bid == G - 1) for (int i = tidx(); i < D / 2; i += NTHR) ((unsigned*)(p.Abuf + (size_t)NROW * D))[i] = 0u;
    return;
  }
  int layer, code;
  if (ph == 1) { layer = 0; code = 10; }
  else if (ph < 12) { layer = 0; code = ph - 2; }
  else { layer = 1; const int q = ph - 12; code = q < 5 ? q : q + 1; if (code == 9) code = 8; }
  bool do_mix = false, do_upd = false;
  const bf16_t* gA = nullptr; const bf16_t* gB = nullptr; int gK = 0, gnM = 0, gpm = 0, gG = 0, gc = 0;
  int uwhich = 0, umode = 0, ubofs = 0, unb = G;
  switch (code) {
    case 10: do_upd = true; uwhich = 0; break;
    case 0: {
      gemm_phase<EPI_P, 0>(p, layer, lds, p.Abuf, p.WinT, D, NROW / 256, INW / 256);
      gemm_phase<EPI_VT, 0>(p, layer, lds, p.WvT, p.Abuf, D, 2, NROW / 256);
      if (G == 256 && bid >= 144) for (int k = 0; k < WPRE / 112; ++k) weight_pair(p, layer, WT_IN, WT_ITEMS, (bid - 144) + k * 112, smem);
    } break;
    case 1: {
      const int nattn = (layer == 0) ? 512 + 64 : 512;
      const int wpre = (G == 256) ? WPRE : 0;
      const int nwa = (WT_ITEMS - WT_IN + 1) / 2 - wpre, nwb = (layer == 0) ? (WT_IN + 1) / 2 : 0;
      const int total = 128 + nattn + nwa + nwb;
      volatile int* slot = (volatile int*)(smem + SMEM_BYTES + 8);
#ifdef PROBE_MIX
      for (int rep = 0; rep < 2; ++rep)
#endif
      for (;;) {
        __syncthreads();
#ifdef PROBE_MIX
        if (tidx() == 0) *slot = (int)xb_add(&p.bar[XB_QUEUE(layer + 2 * rep)], 1u) + (rep == 1 && PROBE_MIX == 2 ? 128 : 0);
        __syncthreads();
        const int it = *slot;
        if (it >= ((rep == 1 && PROBE_MIX == 1) ? 128 : total)) break;
#else
        if (tidx() == 0) *slot = (int)xb_add(&p.bar[XB_QUEUE(layer)], 1u);
        __syncthreads();
        const int it = *slot;
        if (it >= total) break;
#endif
        if (it < 128) {
          const int mx = it & 1, dir = (it >> 1) & 1, h = (it >> 2) & 3, b = (it >> 4) & 7;
          if (mx == 0) scan_item<0>(p, layer, dir, b, h, (float*)smem); else scan_item_gdn(p, layer, dir, b, h, (float*)smem);
        } else if (it < 128 + nattn) attn_item(p, layer, it - 128, smem);
        else if (it < 128 + nattn + nwa) weight_pair(p, layer, WT_IN, WT_ITEMS, wpre + it - 128 - nattn, smem);
        else weight_pair(p, layer + 1, 0, WT_IN, it - 128 - nattn - nwa, smem);
      }
    } break;
    case 2: finish_phase(p, layer); break;
    case 3: do_mix = true; gA = p.Abuf; gB = p.WoutT; gK = D; gnM = NLAT / 256; break;
    case 4:
      if (layer == 0 && G > 64) {
        if (bid < 32) { do_mix = true; gA = p.Abuf; gB = p.WoutT; gK = D; gnM = NCTX / 256; gpm = NLAT / 256; gG = 32; gc = bid; }
        else { do_upd = true; uwhich = 1; umode = 1; ubofs = 32; unb = G - 32; }
      } else if (layer == 0) { do_mix = true; gA = p.Abuf; gB = p.WoutT; gK = D; gnM = NCTX / 256; gpm = NLAT / 256; }
      else { do_upd = true; uwhich = 1; }
      break;
    case 5: do_upd = true; uwhich = 1; umode = (G > 64) ? 2 : 0; break;
    case 6: gemm_phase<EPI_CONV, 1>(p, layer, lds, p.Abuf, p.WupT, D, (layer == 1) ? HB_NLAT / 4 : (HB_NLAT + HB_NCTX) / 4, 22); break;
    case 7: do_mix = true; gA = p.act; gB = p.WdownT; gK = DFF; gnM = NLAT / 256; break;
    case 8:
      if (layer == 0 && G > 64) {
        if (bid < 32) { do_mix = true; gA = p.act; gB = p.WdownT; gK = DFF; gnM = NCTX / 256; gpm = NLAT / 256; gG = 32; gc = bid; }
        else { do_upd = true; uwhich = 2; umode = 1; ubofs = 32; unb = G - 32; }
      } else if (layer == 0) { do_mix = true; gA = p.act; gB = p.WdownT; gK = DFF; gnM = NCTX / 256; gpm = NLAT / 256; }
      else { do_upd = true; uwhich = 2; }
      break;
    case 9: do_upd = true; uwhich = 2; umode = (G > 64) ? 2 : 0; break;
  }
  if (do_mix) gemm_phase<EPI_MIX, 0>(p, layer, lds, gA, gB, gK, gnM, 4, gpm, gG, gc);
  if (do_upd) update_phase(p, layer, uwhich, umode, ubofs, unb);
}

__global__ void __launch_bounds__(NTHR, 2) mega_kernel(Params p) {
  extern __shared__ __attribute__((aligned(16))) unsigned char lds_dyn[];
  char* smem = (char*)lds_dyn;
  volatile LAS unsigned* st = (volatile LAS unsigned*)((LAS unsigned char*)lds_dyn + SMEM_BYTES);
  if (threadIdx.x == 0) { st[0] = 0u; st[1] = 0u; st[2] = 0u; st[3] = 0u; }
  __syncthreads();
  XcdBarrier xb = xcd_barrier_post(p.bar, st);
  if (p.phase_end > 1000) cg::this_grid().sync();
  for (int ph = p.phase_begin; ph < p.phase_end; ++ph) {
    if (ph > p.phase_begin) xcd_barrier(xb);
    run_phase(p, ph, smem);
#ifdef PROBE_MASK
    if (ph >= 2 && ((PROBE_MASK >> ((ph - 2) & 7)) & 1)) { __syncthreads(); run_phase(p, ph, smem); }
    if (ph < 2 && (PROBE_MASK & 0x100)) { __syncthreads(); run_phase(p, ph, smem); }
#endif
  }
}

extern "C" void kernel_launch(void* const* d_in, const int* in_sizes, int n_in, void* d_out, int out_size, void* d_ws, size_t ws_size,
                              hipStream_t stream) {
  Params p{};
  p.x = (const float*)d_in[0]; p.c = (const float*)d_in[1]; p.ctx = (const float*)d_in[2]; p.c_ctx = (const float*)d_in[3];
  p.ada_w = (const float*)d_in[4]; p.ada_b = (const float*)d_in[5]; p.norm_g = (const float*)d_in[6]; p.w_in = (const float*)d_in[7];
  p.w_out = (const float*)d_in[8]; p.da_lambda = (const float*)d_in[9]; p.da_subln_g = (const float*)d_in[10];
  p.hg_lb_logits = (const float*)d_in[11]; p.hg_norm_g = (const float*)d_in[12]; p.gd_conv_w = (const float*)d_in[13];
  p.gd_a_log = (const float*)d_in[14]; p.gd_dt_bias = (const float*)d_in[15]; p.gd_norm_g = (const float*)d_in[16];
  p.ffn_w_up = (const float*)d_in[17]; p.ffn_conv_w = (const float*)d_in[18]; p.ffn_conv_b = (const float*)d_in[19];
  p.ffn_w_down = (const float*)d_in[20];
  p.out = (float*)d_out;
  char* w = (char*)d_ws;
  size_t off = 0;
  auto take = [&](size_t bytes) { char* r = w + off; off += (bytes + 255) & ~(size_t)255; return r; };
  p.WinT = (bf16_t*)take((size_t)INW * D * 2);
  p.WvT = (bf16_t*)take((size_t)512 * D * 2);
  p.WoutT = (bf16_t*)take((size_t)D * D * 2);
  p.WupT = (bf16_t*)take((size_t)2 * DFF * D * 2);
  p.WdownT = (bf16_t*)take((size_t)D * DFF * 2);
  p.mod = (float*)take((size_t)2 * 9 * 6144 * 4);
  p.ropec = (float*)take((size_t)SEQ * 32 * 4);
  p.ropes = (float*)take((size_t)SEQ * 32 * 4);
  p.cx = (float*)take((size_t)NCTX * D * 4);
  p.bar = (unsigned*)take((size_t)BAR_WORDS_TOTAL * 4);
  p.Abuf = (bf16_t*)take((size_t)(NROW + 8) * D * 2);
  char* region = w + off;
  p.P = (bf16_t*)region;
  p.Vt = (bf16_t*)(region + (size_t)NROW * PW * 2);
  p.raw = (bf16_t*)(region + (size_t)NROW * PW * 2 + (size_t)NB * 4 * 128 * NKEY * 2);
  p.mix = (bf16_t*)region;
  p.act = (bf16_t*)(region + (size_t)NROW * D * 4);

  static int grid_blocks = 0;
  if (!grid_blocks) {
    int dev = 0, cus = 0, per_cu = 0;
    (void)hipGetDevice(&dev);
    (void)hipDeviceGetAttribute(&cus, hipDeviceAttributeMultiprocessorCount, dev);
    if (hipFuncSetAttribute((const void*)mega_kernel, hipFuncAttributeMaxDynamicSharedMemorySize, LDS_TOTAL) != hipSuccess)
      fprintf(stderr, "hipFuncSetAttribute(MaxDynamicSharedMemorySize=%d) failed\n", LDS_TOTAL);
    (void)hipOccupancyMaxActiveBlocksPerMultiprocessor(&per_cu, (const void*)mega_kernel, NTHR, LDS_TOTAL);
    (void)hipGetLastError();
    grid_blocks = cus;
  }
  (void)hipMemsetAsync(p.bar, 0, (size_t)BAR_WORDS_TOTAL * 4, stream);
#ifdef MK_MULTI
  for (int ph = 0; ph < NPHASE; ++ph) {
    p.phase_begin = ph; p.phase_end = ph + 1;
    hipLaunchKernelGGL(mega_kernel, dim3(grid_blocks), dim3(NTHR), LDS_TOTAL, stream, p);
  }
#else
  p.phase_begin = 0; p.phase_end = NPHASE;
  void* args[] = {&p};
  hipError_t e = hipLaunchCooperativeKernel((void*)mega_kernel, dim3(grid_blocks), dim3(NTHR), args, LDS_TOTAL, stream);
  if (e != hipSuccess) fprintf(stderr, "cooperative launch failed: %s (grid %d)\n", hipGetErrorString(e), grid_blocks);
#endif
}
```

```cpp
#include <hip/hip_runtime.h>
#include <hip/hip_cooperative_groups.h>
#include <cstdio>
namespace cg = cooperative_groups;

typedef unsigned short bf16_t;
using bf16x8 = __attribute__((ext_vector_type(8))) short;
using f32x4 = __attribute__((ext_vector_type(4))) float;
using u32x4 = __attribute__((ext_vector_type(4))) unsigned;
using u32x2 = __attribute__((ext_vector_type(2))) unsigned;
#define DI __device__ __forceinline__
DI int tidx() { int t = threadIdx.x; asm volatile("" : "+v"(t)); return t; }
DI int bidx() { int t = blockIdx.x; asm volatile("" : "+s"(t)); return t; }
DI u32x4 mk4(unsigned a, unsigned b, unsigned c, unsigned d) { u32x4 r = {a, b, c, d}; return r; }
DI u32x2 mk2(unsigned a, unsigned b) { u32x2 r = {a, b}; return r; }

constexpr int D = 1024, NB = 8, SEQ = 2048, CTXL = 256;
constexpr int NLAT = NB * SEQ, NCTX = NB * CTXL, NROW = NLAT + NCTX;
constexpr int INC = 3856, PW = 3344, DFF = 2816, NKEY = 2304;
constexpr int PC_Q = 0, PC_K = 512, PC_HQ = 1024, PC_HI = 1280, PC_HF = 1536, PC_HG = 2048, PC_GQKV = 2304, PC_GA = 3072, PC_GB = 3080, PC_GG = 3088;
constexpr int SMEM_BYTES = 131072;
constexpr int LDS_TOTAL = SMEM_BYTES + 64;
constexpr int NTHR = 512, NWAVE = 8;
constexpr int INW = 3584;
constexpr int NPHASE = 20;

struct Params {
  const float *x, *c, *ctx, *c_ctx, *ada_w, *ada_b, *norm_g, *w_in, *w_out, *da_lambda, *da_subln_g,
      *hg_lb_logits, *hg_norm_g, *gd_conv_w, *gd_a_log, *gd_dt_bias, *gd_norm_g, *ffn_w_up, *ffn_conv_w, *ffn_conv_b, *ffn_w_down;
  float* out;
  bf16_t *WinT, *WvT, *WoutT, *WupT, *WdownT;
  float *mod, *ropec, *ropes, *cx;
  bf16_t *Abuf, *P, *Vt, *raw;
  bf16_t* mix;
  bf16_t* act;
  unsigned* bar;
  int phase_begin, phase_end;
};

typedef __bf16 hbf2 __attribute__((ext_vector_type(2)));
typedef float f32x2 __attribute__((ext_vector_type(2)));
DI unsigned pack2(float a, float b) { f32x2 v = {a, b}; hbf2 r = __builtin_convertvector(v, hbf2); return __builtin_bit_cast(unsigned, r); }
DI bf16_t f2bf(float x) { return (bf16_t)(pack2(x, x) & 0xffffu); }
DI float bf2f(bf16_t h) { return __uint_as_float(((unsigned)h) << 16); }
DI float silu_f(float x) { return x / (1.f + __expf(-x)); }
DI float sigmoid_f(float x) { return 1.f / (1.f + __expf(-x)); }
DI float quad_sum(float v) {
  int i = __float_as_int(v);
  v += __int_as_float(__builtin_amdgcn_update_dpp(0, i, 0xB1, 0xF, 0xF, true));
  i = __float_as_int(v);
  v += __int_as_float(__builtin_amdgcn_update_dpp(0, i, 0x4E, 0xF, 0xF, true));
  return v;
}
DI void unpack8(u32x4 u, float* f) {
  f[0] = __uint_as_float(u.x << 16); f[1] = __uint_as_float(u.x & 0xffff0000u);
  f[2] = __uint_as_float(u.y << 16); f[3] = __uint_as_float(u.y & 0xffff0000u);
  f[4] = __uint_as_float(u.z << 16); f[5] = __uint_as_float(u.z & 0xffff0000u);
  f[6] = __uint_as_float(u.w << 16); f[7] = __uint_as_float(u.w & 0xffff0000u);
}


#define XB_TMO      128
#define XB_XCNT(j)  (256  + 64 * (j))
#define XB_XSUB(j)  (1280 + 64 * (j))
#define XB_XGEN(j)  (2304 + 64 * (j))
#define XB_TOP      3328
#define XB_TOPGEN   3392
#define XCD_BAR_WORDS 3456
#define XB_QUEUE(l) (3456 + 64 * (l))
#define BAR_WORDS_TOTAL 3712
#define XB_SPIN_CAP (1u << 23)
#define LAS __attribute__((address_space(3)))
DI unsigned xb_ld(unsigned* p) { return __hip_atomic_load(p, __ATOMIC_RELAXED, __HIP_MEMORY_SCOPE_AGENT); }
DI unsigned xb_add(unsigned* p, unsigned v) { return __hip_atomic_fetch_add(p, v, __ATOMIC_RELAXED, __HIP_MEMORY_SCOPE_AGENT); }
DI unsigned xb_xcc_id() { return (unsigned)__builtin_amdgcn_s_getreg((3 << 11) | 20) & 0xFu; }
#define XB_SPIN(cond, bar) do { unsigned _sp = 0; while (cond) { __builtin_amdgcn_s_sleep(1); \
    if ((++_sp & 255u) == 0u) { if (xb_ld(&(bar)[XB_TMO])) break; if (_sp > XB_SPIN_CAP) { atomicAdd(&(bar)[XB_TMO], 1u); break; } } } } while (0)
struct XcdBarrier { unsigned* bar; unsigned x; volatile LAS unsigned* st; };
DI XcdBarrier xcd_barrier_post(unsigned* bar, volatile LAS unsigned* st) {
  XcdBarrier b; b.bar = bar; b.x = xb_xcc_id(); b.st = st;
  if (threadIdx.x == 0) (void)xb_add(&bar[XB_XCNT(b.x)], 1u);
  return b;
}
DI void xcd_barrier_complete(unsigned* bar, unsigned x, unsigned& nloc, unsigned& nx) {
  const unsigned G = gridDim.x * gridDim.y * gridDim.z;
  unsigned sum, cnt, mine, sp = 0u;
  for (;;) {
    sum = 0u; cnt = 0u; mine = 0u;
#pragma unroll
    for (unsigned j = 0; j < 16; ++j) { const unsigned c = xb_ld(&bar[XB_XCNT(j)]); sum += c; cnt += (c > 0u) ? 1u : 0u; mine = (j == x) ? c : mine; }
    if (sum == G) break;
    __builtin_amdgcn_s_sleep(1);
    if ((++sp & 255u) == 0u) { if (xb_ld(&bar[XB_TMO])) break; if (sp > XB_SPIN_CAP) { atomicAdd(&bar[XB_TMO], 1u); break; } }
  }
  nloc = mine > 0u ? mine : 1u; nx = cnt > 0u ? cnt : 1u;
}
DI void xcd_barrier(const XcdBarrier& b) {
  asm volatile("s_waitcnt vmcnt(0)" ::: "memory");
  __syncthreads();
  if (threadIdx.x == 0) {
    unsigned* bar = b.bar;
    __builtin_amdgcn_s_waitcnt(0);
    unsigned nloc = b.st[0], nx = b.st[1];
    if (nloc == 0u) { xcd_barrier_complete(bar, b.x, nloc, nx); b.st[0] = nloc; b.st[1] = nx; }
    const unsigned old = xb_add(&bar[XB_XSUB(b.x)], 1u);
    const unsigned gen = old / nloc;
    if (old + 1u == (gen + 1u) * nloc) {
      __builtin_amdgcn_fence(__ATOMIC_RELEASE, "agent");
      asm volatile("s_waitcnt vmcnt(0)" ::: "memory");
      const unsigned og = xb_add(&bar[XB_TOP], 1u);
      const unsigned tg = og / nx;
      if (og + 1u == (tg + 1u) * nx) xb_add(&bar[XB_TOPGEN], 1u);
      else XB_SPIN(xb_ld(&bar[XB_TOPGEN]) == tg, bar);
      __builtin_amdgcn_fence(__ATOMIC_ACQUIRE, "agent");
      xb_add(&bar[XB_XGEN(b.x)], 1u);
      asm volatile("s_waitcnt vmcnt(0)" ::: "memory");
    } else {
      XB_SPIN(xb_ld(&bar[XB_XGEN(b.x)]) == gen, bar);
      __builtin_amdgcn_fence(__ATOMIC_ACQUIRE, "agent");
      asm volatile("s_waitcnt vmcnt(0)" ::: "memory");
    }
  }
  __syncthreads();
}

DI void transpose_tile(const float* __restrict__ W, int K, int N, bf16_t* __restrict__ WT, bf16_t* __restrict__ WT2, int kt, int nt, int mode, float* lds, bool valid) {
  const int tid = tidx() & 255;
  const int k0 = kt * 64, n0 = nt * 64;
  if (valid) {
#pragma unroll
    for (int pp = 0; pp < 4; ++pp) {
      int r = pp * 16 + (tid >> 4), c = (tid & 15) * 4;
      float4 v = make_float4(0.f, 0.f, 0.f, 0.f);
      int n = n0 + c;
      if (n + 3 < N) { const f32x4 t4 = __builtin_nontemporal_load((const f32x4*)(W + (size_t)(k0 + r) * N + n)); v = make_float4(t4[0], t4[1], t4[2], t4[3]); }
      lds[r * 65 + c + 0] = v.x; lds[r * 65 + c + 1] = v.y; lds[r * 65 + c + 2] = v.z; lds[r * 65 + c + 3] = v.w;
    }
  }
  __syncthreads();
  if (valid) {
    int nl = tid >> 2, kq = tid & 3;
    int n = n0 + nl;
    bf16_t* dstbase = WT;
    int orow = n;
    if (mode == 1) orow = (n < DFF) ? ((n >> 7) * 256 + (n & 127)) : (((n - DFF) >> 7) * 256 + 128 + ((n - DFF) & 127));
    if (mode == 2) {
      if (n < 1024) { const int d = n & 63; orow = (n & ~63) + (d < 32 ? 2 * d : 2 * (d - 32) + 1); }
      else if (n < 1536) { orow = n - 1024; dstbase = WT2; }
      else orow = n - 512;
    }
    if (n < N) {
      unsigned w[8];
#pragma unroll
      for (int i = 0; i < 8; ++i) w[i] = pack2(lds[(kq * 16 + 2 * i) * 65 + nl], lds[(kq * 16 + 2 * i + 1) * 65 + nl]);
      u32x4* dst = (u32x4*)(dstbase + (size_t)orow * K + k0 + kq * 16);
      dst[0] = mk4(w[0], w[1], w[2], w[3]);
      dst[1] = mk4(w[4], w[5], w[6], w[7]);
    }
  }
  __syncthreads();
}

constexpr int WT_IN = 16 * 61, WT_OUT = 16 * 16, WT_UP = 16 * 88, WT_DOWN = 44 * 16;
constexpr int WT_ITEMS = WT_IN + WT_OUT + WT_UP + WT_DOWN;
constexpr int WPRE = 112 * 7;
DI void weight_item(const Params& p, int layer, int it, float* lds, bool valid) {
  if (it < WT_IN) { transpose_tile(p.w_in + (size_t)layer * D * INC, D, INC, p.WinT, p.WvT, it % 16, it / 16, 2, lds, valid); return; }
  it -= WT_IN;
  if (it < WT_OUT) { transpose_tile(p.w_out + (size_t)layer * D * D, D, D, p.WoutT, nullptr, it % 16, it / 16, 0, lds, valid); return; }
  it -= WT_OUT;
  if (it < WT_UP) { transpose_tile(p.ffn_w_up + (size_t)layer * D * 2 * DFF, D, 2 * DFF, p.WupT, nullptr, it % 16, it / 16, 1, lds, valid); return; }
  it -= WT_UP;
  transpose_tile(p.ffn_w_down + (size_t)layer * DFF * D, DFF, D, p.WdownT, nullptr, it % 44, it / 44, 0, lds, valid);
}
DI void weight_pair(const Params& p, int layer, int first, int last, int pair, char* smem) {
  const int half = tidx() >> 8;
  float* lds = (float*)smem + half * 4224;
  const int it = first + pair * 2 + half;
  const bool valid = it < last;
  weight_item(p, layer, valid ? it : last - 1, lds, valid);
}

DI void mod_item(const Params& p, int it2, float* lds) {
  const int tid = tidx() & 255, half = tidx() >> 8;
  const int it = it2 * 2 + half;
  const int layer = it / 192, n0 = (it % 192) * 32;
  float* sc = lds;
  float* red = lds + 9 * 1024 + half * 2304;
  for (int i = tidx(); i < 9 * 1024; i += NTHR) {
    float v = (i < 8 * 1024) ? p.c[i] : p.c_ctx[i - 8 * 1024];
    sc[i] = silu_f(v);
  }
  __syncthreads();
  const int kg = tid >> 5, col = tid & 31;
  float acc[9];
#pragma unroll
  for (int i = 0; i < 9; ++i) acc[i] = 0.f;
  const float* w = p.ada_w + (size_t)layer * D * 6144 + n0 + col;
#pragma unroll 8
  for (int k = kg * 128; k < kg * 128 + 128; ++k) {
    float wv = __builtin_nontemporal_load(w + (size_t)k * 6144);
#pragma unroll
    for (int i = 0; i < 9; ++i) acc[i] += sc[i * 1024 + k] * wv;
  }
#pragma unroll
  for (int i = 0; i < 9; ++i) red[(kg * 9 + i) * 32 + col] = acc[i];
  __syncthreads();
  for (int t = tid; t < 288; t += 256) {
    int i = t >> 5, cc = t & 31;
    float sacc = p.ada_b[layer * 6144 + n0 + cc];
#pragma unroll
    for (int g = 0; g < 8; ++g) sacc += red[(g * 9 + i) * 32 + cc];
    p.mod[(size_t)(layer * 9 + i) * 6144 + n0 + cc] = sacc;
  }
  __syncthreads();
}

DI void rope_item(const Params& p, int it) {
  for (int i = 0; i < 2; ++i) {
    int idx = it * 1024 + i * 512 + tidx();
    int t = idx >> 5, j = idx & 31;
    float pos = (float)((j < 16) ? (t >> 6) : (t & 63));
    float inv = exp2f(-(float)(j & 15) * (13.287712379549449f / 16.f));
    float ang = pos * inv;
    double rev = (double)ang * 0.15915494309189535;
    rev -= floor(rev);
    float fr = (float)rev;
    p.ropec[idx] = __builtin_amdgcn_cosf(fr);
    p.ropes[idx] = __builtin_amdgcn_sinf(fr);
  }
}

DI float wave_sum(float v) {
#pragma unroll
  for (int o = 32; o >= 1; o >>= 1) v += __shfl_xor(v, o);
  return v;
}
DI void update_phase(const Params& p, int layer, int which, int mode, int bofs, int nb) {
  const int lane = tidx() & 63, wid = tidx() >> 6;
  const int nrows = (layer == 1) ? NLAT : NROW;
  const bool last = (layer == 1 && which == 2);
  const int gw = (bidx() - bofs) * NWAVE + wid, nw = nb * NWAVE;
  const int nl = (which == 2) ? layer + 1 : layer;
  const int gi = (which == 1) ? 2 : 0, sh = (which == 1) ? 3 : 0;
  const bool from_in = (layer == 0 && which <= 1);
  float4 pg[4], pgt[4], ng[4], nsf[4], nsc[4];
  auto load_params = [&](int mi) {
    const float* modp = p.mod + (size_t)(layer * 9 + mi) * 6144;
    const float* gate = modp + (which == 1 ? 2 : 5) * 1024;
    const float* gp = p.norm_g + (size_t)(layer * 4 + (which == 1 ? 1 : 3)) * 1024;
    const float* modn = p.mod + (size_t)(nl * 9 + mi) * 6144;
    const float* gn = p.norm_g + (size_t)(nl * 4 + gi) * 1024;
#pragma unroll
    for (int i = 0; i < 4; ++i) {
      if (which != 0) { pg[i] = *(const float4*)(gp + i * 256 + lane * 4); pgt[i] = *(const float4*)(gate + i * 256 + lane * 4); }
      if (!last) {
        ng[i] = *(const float4*)(gn + i * 256 + lane * 4);
        nsf[i] = *(const float4*)(modn + sh * 1024 + i * 256 + lane * 4);
        nsc[i] = *(const float4*)(modn + (sh + 1) * 1024 + i * 256 + lane * 4);
      }
    }
  };
  auto row_src = [&](int r) -> const float* {
    if (r < NLAT) return from_in ? p.x + (size_t)r * D : p.out + (size_t)r * D;
    return from_in ? p.ctx + (size_t)(r - NLAT) * D : p.cx + (size_t)(r - NLAT) * D;
  };
  auto load_row = [&](int r, float4 (&xv)[4], u32x2 (&um)[4]) {
    const float* xs = row_src(r);
#pragma unroll
    for (int i = 0; i < 4; ++i) { const f32x4 t4 = __builtin_nontemporal_load((const f32x4*)(xs + i * 256 + lane * 4)); xv[i] = make_float4(t4[0], t4[1], t4[2], t4[3]); }
    if (which != 0) {
      const bf16_t* mr = p.mix + (size_t)r * D;
#pragma unroll
      for (int i = 0; i < 4; ++i) um[i] = __builtin_nontemporal_load((const u32x2*)(mr + i * 256 + lane * 4));
    }
  };
  auto do_row = [&](int r, float4 (&xv)[4], const u32x2 (&um)[4]) {
    float* xd = (r < NLAT) ? p.out + (size_t)r * D : p.cx + (size_t)(r - NLAT) * D;
    if (which != 0) {
      float4 mv[4];
      float ss = 0.f;
#pragma unroll
      for (int i = 0; i < 4; ++i) {
        mv[i] = make_float4(__uint_as_float(um[i].x << 16), __uint_as_float(um[i].x & 0xffff0000u), __uint_as_float(um[i].y << 16), __uint_as_float(um[i].y & 0xffff0000u));
        ss += mv[i].x * mv[i].x + mv[i].y * mv[i].y + mv[i].z * mv[i].z + mv[i].w * mv[i].w;
      }
      ss = wave_sum(ss);
      const float rstd = rsqrtf(ss * (1.f / 1024.f) + 1e-6f);
#pragma unroll
      for (int i = 0; i < 4; ++i) {
        xv[i].x += pgt[i].x * (mv[i].x * rstd * pg[i].x);
        xv[i].y += pgt[i].y * (mv[i].y * rstd * pg[i].y);
        xv[i].z += pgt[i].z * (mv[i].z * rstd * pg[i].z);
        xv[i].w += pgt[i].w * (mv[i].w * rstd * pg[i].w);
        { const f32x4 t4 = {xv[i].x, xv[i].y, xv[i].z, xv[i].w}; __builtin_nontemporal_store(t4, (f32x4*)(xd + i * 256 + lane * 4)); }
      }
    }
    if (!last) {
      float ss = 0.f;
#pragma unroll
      for (int i = 0; i < 4; ++i) ss += xv[i].x * xv[i].x + xv[i].y * xv[i].y + xv[i].z * xv[i].z + xv[i].w * xv[i].w;
      ss = wave_sum(ss);
      const float rstd = rsqrtf(ss * (1.f / 1024.f) + 1e-6f);
      bf16_t* dst = p.Abuf + (size_t)r * D;
#pragma unroll
      for (int i = 0; i < 4; ++i) {
        float a = (xv[i].x * rstd * ng[i].x) * (1.f + nsc[i].x) + nsf[i].x;
        float b = (xv[i].y * rstd * ng[i].y) * (1.f + nsc[i].y) + nsf[i].y;
        float c = (xv[i].z * rstd * ng[i].z) * (1.f + nsc[i].z) + nsf[i].z;
        float d = (xv[i].w * rstd * ng[i].w) * (1.f + nsc[i].w) + nsf[i].w;
        *(u32x2*)(dst + i * 256 + lane * 4) = mk2(pack2(a, b), pack2(c, d));
      }
    }
  };
  if (mode == 2) {
    float4 xa[4];
    u32x2 ma[4];
    load_params(8);
    for (int rc = NLAT + gw; rc < NROW; rc += nw) { load_row(rc, xa, ma); do_row(rc, xa, ma); }
  } else if ((nw & 7) == 0 && nw <= 8 * SEQ) {
    const int wpb = nw >> 3, bb = gw / wpb, wl = gw % wpb;
    load_params(bb);
    float4 xa[4], xb[4];
    u32x2 ma[4], mb[4];
    int r = bb * SEQ + wl;
    const int rend = (bb + 1) * SEQ;
    if (r < rend) load_row(r, xa, ma);
    while (r < rend) {
      const int r2 = r + wpb;
      if (r2 < rend) load_row(r2, xb, mb);
      do_row(r, xa, ma);
      if (r2 >= rend) break;
      const int r3 = r2 + wpb;
      if (r3 < rend) load_row(r3, xa, ma);
      do_row(r2, xb, mb);
      r = r3;
    }
    if (mode == 0 && nrows > NLAT) {
      load_params(8);
      for (int rc = NLAT + gw; rc < NROW; rc += nw) { load_row(rc, xa, ma); do_row(rc, xa, ma); }
    }
  } else {
    float4 xa[4];
    u32x2 ma[4];
    for (int r = gw; r < (mode == 1 ? NLAT : nrows); r += nw) { load_params((r < NLAT) ? (r >> 11) : 8); load_row(r, xa, ma); do_row(r, xa, ma); }
  }
}

constexpr int EPI_P = 0, EPI_MIX = 1, EPI_CONV = 2, EPI_VT = 3;
constexpr int G_BM = 256, G_BK = 64, G_HALF = 128, G_HTB = G_HALF * G_BK * 2, G_STAGE_BYTES = 8 * G_HTB, G_NXCD = 8, G_WGM = 8;
constexpr int HB_LAT = 34, HB_CTX = 5, HB_NLAT = NB * HB_LAT, HB_NCTX = NB * HB_CTX;
DI int g_lds_byte(int r, int c) { const int st = (r >> 4) * 2 + (c >> 5), rr = r & 15, cc = c & 31, ob = rr * 64 + cc * 2; return st * 1024 + (ob ^ (((ob >> 9) & 1) << 5)); }
DI void g_stage_rc(int b, int& R, int& C) { const int st = b / 1024, sb = b % 1024, swz = sb ^ (((sb >> 9) & 1) << 5); R = (st >> 1) * 16 + swz / 64; C = (st & 1) * 32 + (swz % 64) / 2; }
DI int g_perm32(int rho) { const int n = rho >> 4, i = rho & 15; return 8 * (i >> 2) + 4 * n + (i & 3); }
struct GUnit { int pm, pn; };
struct GOrder {
  int nM, nN, nwg, G, c;
  DI void init(int nM_, int nN_, int G_, int c_) { nM = nM_; nN = nN_; nwg = nM * nN; G = G_; c = c_; }
  DI bool next(int i, GUnit& u) const {
    const long L = (long)i * G + c; if (L >= nwg) return false;
    int wgid = (int)L; { const int q = nwg / G_NXCD, r = nwg % G_NXCD, xcd = wgid % G_NXCD, off = wgid / G_NXCD; wgid = (xcd < r ? xcd * (q + 1) : r * (q + 1) + (xcd - r) * q) + off; }
    const int nig = G_WGM * nN, gid = wgid / nig, fm = gid * G_WGM, gsz = (nM - fm) < G_WGM ? (nM - fm) : G_WGM;
    u.pm = fm + ((wgid % nig) % gsz); u.pn = (wgid % nig) / gsz; return true;
  }
};
DI void halo_block(int blk, int& base, int& L, int& t0) {
  if (blk < HB_NLAT) { const int s = blk / HB_LAT, i = blk % HB_LAT; base = s * SEQ; L = SEQ; t0 = 62 * i - 1; }
  else { const int b2 = blk - HB_NLAT; const int s = b2 / HB_CTX, i = b2 % HB_CTX; base = NLAT + s * CTXL; L = CTXL; t0 = 62 * i - 1; }
}
template <int AMODE>
DI void g_a_offsets(int pm, int K, const int (&R)[2], const int (&C)[2], unsigned (&o)[2][2]) {
#pragma unroll
  for (int h = 0; h < 2; ++h)
#pragma unroll
    for (int i = 0; i < 2; ++i) {
      const int tr = h * 128 + R[i];
      int grow;
      if (AMODE == 0) grow = pm * 256 + tr;
      else {
        int base, L, t0; halo_block(pm * 4 + (tr >> 6), base, L, t0);
        const int t = t0 + (tr & 63);
        grow = (t >= 0 && t < L) ? base + t : NROW;
      }
      o[h][i] = (unsigned)(grow * K + C[i]) * 2u;
    }
}

template <int EPI> DI void g_epilogue(const Params& p, int layer, const f32x4 (&acc)[2][2][4][2], const GUnit& u, int wr, int wc, int fr, int fq);

template <int EPI, int AMODE>
DI void gemm_phase(const Params& p, int layer, LAS unsigned char* lds, const bf16_t* A, const bf16_t* Bt, int K, int nM, int nN, int pm_base = 0, int Gov = 0, int cov = 0) {
  const int tid = tidx(), wid = __builtin_amdgcn_readfirstlane(tid >> 6), lane = tid & 63, wr = wid >> 2, wc = wid & 3, fr = lane & 15, fq = lane >> 4;
  const int nt = K / G_BK;
  int sR[2], sC[2];
  unsigned voffB[2];
#pragma unroll
  for (int i = 0; i < 2; ++i) { g_stage_rc(tid * 16 + i * 8192, sR[i], sC[i]); const int Rb = (sR[i] & ~31) + g_perm32(sR[i] & 31); voffB[i] = (unsigned)(Rb * K + sC[i]) * 2u; }
  const size_t kstep = (size_t)(G_BK * 2);
  const size_t hstep = (size_t)G_HALF * K * 2;
  const size_t tstep = 2 * hstep;
  const unsigned ldsw = (unsigned)wid * 1024u;
  const int aoff = g_lds_byte(wr * 64 + fr, fq * 8), boff = g_lds_byte(wc * 32 + fr, fq * 8);
  const char* gA = (const char*)A;
#define PG8_SA(b, h) (((b) * 2 + (h)) * G_HTB)
#define PG8_SB(b, h) ((4 + (b) * 2 + (h)) * G_HTB)
#define PG8_STAGE(bufoff, gbase, voff) do { _Pragma("unroll") for (int _i = 0; _i < 2; ++_i) \
    __builtin_amdgcn_global_load_lds((const unsigned*)((const char*)(gbase) + (voff)[_i]), (LAS unsigned*)(lds + (bufoff) + ldsw + _i * 8192), 16, 0, 0); } while (0)
#define PG8_LDA(dst, b, h) do { _Pragma("unroll") for (int m = 0; m < 4; ++m) _Pragma("unroll") for (int k = 0; k < 2; ++k) dst[m][k] = *(const LAS bf16x8*)(lds + PG8_SA(b, h) + aoff + m * 2048 + k * 1024); } while (0)
#define PG8_LDB(dst, b, h) do { _Pragma("unroll") for (int n = 0; n < 2; ++n) _Pragma("unroll") for (int k = 0; k < 2; ++k) dst[n][k] = *(const LAS bf16x8*)(lds + PG8_SB(b, h) + boff + n * 2048 + k * 1024); } while (0)
#define PG8_MMA(ai, bj, At, Bt_) do { __builtin_amdgcn_s_setprio(1); _Pragma("unroll") for (int m = 0; m < 4; ++m) _Pragma("unroll") for (int n = 0; n < 2; ++n) _Pragma("unroll") for (int k = 0; k < 2; ++k) \
    acc[ai][bj][m][n] = __builtin_amdgcn_mfma_f32_16x16x32_bf16(Bt_[n][k], At[m][k], acc[ai][bj][m][n], 0, 0, 0); __builtin_amdgcn_s_setprio(0); } while (0)
#define PG8_WAIT_V(n) asm volatile("s_waitcnt vmcnt(" #n ")" ::: "memory")
#define PG8_WAIT_L(n) asm volatile("s_waitcnt lgkmcnt(" #n ")" ::: "memory")
#define PG8_BAR __builtin_amdgcn_s_barrier()
#define PG8_SCHED __builtin_amdgcn_sched_barrier(0)
  GOrder S; S.init(nM, nN, Gov ? Gov : (int)gridDim.x, Gov ? cov : bidx());
  GUnit cur, nxt; int ui = 0;
  if (!S.next(0, cur)) return;
  cur.pm += pm_base;
  f32x4 acc[2][2][4][2];
#pragma unroll
  for (int a = 0; a < 2; ++a)
#pragma unroll
    for (int b = 0; b < 2; ++b)
#pragma unroll
      for (int m = 0; m < 4; ++m)
#pragma unroll
        for (int n = 0; n < 2; ++n) acc[a][b][m][n] = (f32x4){0.f, 0.f, 0.f, 0.f};
  bf16x8 At[4][2], B0[2][2], B1[2][2];
  unsigned curA[2][2];
  g_a_offsets<AMODE>(cur.pm, K, sR, sC, curA);
  const char* cB = (const char*)Bt + (size_t)cur.pn * tstep;
  PG8_STAGE(PG8_SB(0, 0), cB, voffB); PG8_STAGE(PG8_SA(0, 0), gA, curA[0]); PG8_STAGE(PG8_SB(0, 1), cB + hstep, voffB); PG8_STAGE(PG8_SA(0, 1), gA, curA[1]);
  if (wr == 1) PG8_BAR;
  PG8_WAIT_V(4); PG8_BAR;
  PG8_STAGE(PG8_SB(1, 0), cB + kstep, voffB); PG8_STAGE(PG8_SA(1, 0), gA + kstep, curA[0]); PG8_STAGE(PG8_SB(1, 1), cB + hstep + kstep, voffB);
  PG8_WAIT_V(6); PG8_BAR;
  for (;;) {
    {
      const int tid2 = tidx();
#pragma unroll
      for (int i = 0; i < 2; ++i) { g_stage_rc(tid2 * 16 + i * 8192, sR[i], sC[i]); const int Rb = (sR[i] & ~31) + g_perm32(sR[i] & 31); voffB[i] = (unsigned)(Rb * K + sC[i]) * 2u; }
      g_a_offsets<AMODE>(cur.pm, K, sR, sC, curA);
    }
    const bool has_next = S.next(ui + 1, nxt);
    if (has_next) nxt.pm += pm_base;
    const int npm = has_next ? nxt.pm : cur.pm;
    const char* nB = has_next ? (const char*)Bt + (size_t)nxt.pn * tstep : cB;
    for (int t = 0; t < nt; t += 2) {
      const bool last = (t == nt - 2);
      const char* a1 = gA + (size_t)(t + 1) * kstep;
      const char* a2 = last ? gA : gA + (size_t)(t + 2) * kstep;
      const char* b2 = last ? nB : cB + (size_t)(t + 2) * kstep;
      const char* a3 = a2 + kstep; const char* b3 = b2 + kstep;
      unsigned a2o[2][2];
      if (last) g_a_offsets<AMODE>(npm, K, sR, sC, a2o);
      else {
#pragma unroll
        for (int h = 0; h < 2; ++h)
#pragma unroll
          for (int i = 0; i < 2; ++i) a2o[h][i] = curA[h][i];
      }
      PG8_LDB(B0, 0, 0); PG8_SCHED; PG8_LDA(At, 0, 0); PG8_STAGE(PG8_SA(1, 1), a1, curA[1]);
      PG8_WAIT_L(8); PG8_BAR; PG8_WAIT_L(0); PG8_MMA(0, 0, At, B0); PG8_BAR; PG8_SCHED;
      PG8_LDB(B1, 0, 1); PG8_STAGE(PG8_SB(0, 0), b2, voffB);
      PG8_BAR; PG8_WAIT_L(0); PG8_MMA(0, 1, At, B1); PG8_BAR;
      PG8_LDA(At, 0, 1); PG8_STAGE(PG8_SA(0, 0), a2, a2o[0]);
      PG8_BAR; PG8_WAIT_L(0); PG8_MMA(1, 0, At, B0); PG8_BAR; PG8_SCHED;
      PG8_STAGE(PG8_SB(0, 1), b2 + hstep, voffB);
      PG8_WAIT_V(6); PG8_BAR; PG8_MMA(1, 1, At, B1); PG8_BAR;
      PG8_LDB(B0, 1, 0); PG8_SCHED; PG8_LDA(At, 1, 0); PG8_STAGE(PG8_SA(0, 1), a2, a2o[1]);
      PG8_WAIT_L(8); PG8_BAR; PG8_WAIT_L(0); PG8_MMA(0, 0, At, B0); PG8_BAR; PG8_SCHED;
      PG8_LDB(B1, 1, 1); PG8_STAGE(PG8_SB(1, 0), b3, voffB);
      PG8_BAR; PG8_WAIT_L(0); PG8_MMA(0, 1, At, B1); PG8_BAR;
      PG8_LDA(At, 1, 1); PG8_STAGE(PG8_SA(1, 0), a3, a2o[0]);
      PG8_BAR; PG8_WAIT_L(0); PG8_MMA(1, 0, At, B0); PG8_BAR; PG8_SCHED;
      PG8_STAGE(PG8_SB(1, 1), b3 + hstep, voffB);
      PG8_WAIT_V(6); PG8_BAR; PG8_MMA(1, 1, At, B1); PG8_BAR;
    }
    g_epilogue<EPI>(p, layer, acc, cur, wr, wc, fr, fq);
    if (!has_next) break;
#pragma unroll
    for (int a = 0; a < 2; ++a)
#pragma unroll
      for (int b = 0; b < 2; ++b)
#pragma unroll
        for (int m = 0; m < 4; ++m)
#pragma unroll
          for (int n = 0; n < 2; ++n) acc[a][b][m][n] = (f32x4){0.f, 0.f, 0.f, 0.f};
    cur = nxt; cB = nB; ++ui;
  }
  PG8_WAIT_V(0);
  if (wr == 0) PG8_BAR;
  PG8_BAR;
#undef PG8_SA
#undef PG8_SB
#undef PG8_STAGE
#undef PG8_LDA
#undef PG8_LDB
#undef PG8_MMA
#undef PG8_WAIT_V
#undef PG8_WAIT_L
#undef PG8_BAR
#undef PG8_SCHED
}

DI float dpp_ror1(float v) { return __int_as_float(__builtin_amdgcn_update_dpp(0, __float_as_int(v), 0x121, 0xF, 0xF, true)); }
DI float dpp_ror15(float v) { return __int_as_float(__builtin_amdgcn_update_dpp(0, __float_as_int(v), 0x12F, 0xF, 0xF, true)); }
template <int EPI>
DI void g_epilogue(const Params& p, int layer, const f32x4 (&acc)[2][2][4][2], const GUnit& u, int wr, int wc, int fr, int fq) {
  if (EPI == EPI_MIX) {
#pragma unroll
    for (int ai = 0; ai < 2; ++ai)
#pragma unroll
      for (int m = 0; m < 4; ++m) {
        bf16_t* rowp = p.mix + (size_t)(u.pm * 256 + ai * 128 + wr * 64 + m * 16 + fr) * D + u.pn * 256 + wc * 32 + 8 * fq;
#pragma unroll
        for (int bj = 0; bj < 2; ++bj) {
          const f32x4 v0 = acc[ai][bj][m][0], v1 = acc[ai][bj][m][1];
          *(u32x4*)(rowp + bj * 128) = mk4(pack2(v0[0], v0[1]), pack2(v0[2], v0[3]), pack2(v1[0], v1[1]), pack2(v1[2], v1[3]));
        }
      }
  } else if (EPI == EPI_P) {
    const bool is_lat = (u.pm * 256) < NLAT;
    const bool qk = u.pn < 4;
    const float qs = (u.pn < 2) ? (0.125f * 1.4426950408889634f) : 1.f;
#pragma unroll
    for (int ai = 0; ai < 2; ++ai)
#pragma unroll
      for (int m = 0; m < 4; ++m) {
        const int row = u.pm * 256 + ai * 128 + wr * 64 + m * 16 + fr;
        bf16_t* rowp = p.P + (size_t)row * PW + u.pn * 256 + wc * 32 + 8 * fq;
        f32x4 cs = {1.f, 1.f, 1.f, 1.f}, sn = {0.f, 0.f, 0.f, 0.f};
        if (qk && is_lat) {
          const int t = row & (SEQ - 1), d0 = (wc & 1) * 16 + 4 * fq;
          cs = *(const f32x4*)(p.ropec + t * 32 + d0);
          sn = *(const f32x4*)(p.ropes + t * 32 + d0);
        }
#pragma unroll
        for (int bj = 0; bj < 2; ++bj) {
          f32x4 v0 = acc[ai][bj][m][0], v1 = acc[ai][bj][m][1];
          if (qk) {
            const f32x4 w0 = {v0[0] * cs[0] - v0[1] * sn[0], v0[1] * cs[0] + v0[0] * sn[0], v0[2] * cs[1] - v0[3] * sn[1], v0[3] * cs[1] + v0[2] * sn[1]};
            const f32x4 w1 = {v1[0] * cs[2] - v1[1] * sn[2], v1[1] * cs[2] + v1[0] * sn[2], v1[2] * cs[3] - v1[3] * sn[3], v1[3] * cs[3] + v1[2] * sn[3]};
            v0 = w0 * qs; v1 = w1 * qs;
          }
          const int col = u.pn * 256 + bj * 128 + wc * 32 + 8 * fq;
          if (col < PW) *(u32x4*)(rowp + bj * 128) = mk4(pack2(v0[0], v0[1]), pack2(v0[2], v0[3]), pack2(v1[0], v1[1]), pack2(v1[2], v1[3]));
        }
      }
  } else if (EPI == EPI_VT) {
#pragma unroll
    for (int ai = 0; ai < 2; ++ai)
#pragma unroll
      for (int m = 0; m < 4; ++m) {
        const int hh = u.pm * 2 + ai, dv = wr * 64 + m * 16 + fr;
#pragma unroll
        for (int bj = 0; bj < 2; ++bj) {
          const int tok = u.pn * 256 + bj * 128 + wc * 32 + 8 * fq;
          int bb, key;
          if (tok < NLAT) { bb = tok >> 11; key = CTXL + (tok & (SEQ - 1)); } else { bb = (tok - NLAT) >> 8; key = (tok - NLAT) & (CTXL - 1); }
          const f32x4 v0 = acc[ai][bj][m][0], v1 = acc[ai][bj][m][1];
          *(u32x4*)(p.Vt + ((size_t)((bb * 4 + hh) * 128 + dv)) * NKEY + key) = mk4(pack2(v0[0], v0[1]), pack2(v0[2], v0[3]), pack2(v1[0], v1[1]), pack2(v1[2], v1[3]));
        }
      }
  } else {
    const int f0 = u.pn * 128 + wc * 32 + 8 * fq;
    const float* cw = p.ffn_conv_w + (size_t)layer * 3 * 2 * DFF + f0;
    const float* cbp = p.ffn_conv_b + (size_t)layer * 2 * DFF + f0;
#pragma unroll
    for (int q = 0; q < 2; ++q) {
      f32x4 wg[3], wv[3], bg, bv;
#pragma unroll
      for (int j = 0; j < 3; ++j) { wg[j] = *(const f32x4*)(cw + j * 2 * DFF + 4 * q); wv[j] = *(const f32x4*)(cw + j * 2 * DFF + DFF + 4 * q); }
      bg = *(const f32x4*)(cbp + 4 * q); bv = *(const f32x4*)(cbp + DFF + 4 * q);
#pragma unroll
      for (int ai = 0; ai < 2; ++ai) {
        int base, L, t0; halo_block(u.pm * 4 + ai * 2 + wr, base, L, t0);
#pragma unroll
        for (int m = 0; m < 4; ++m) {
          const int r = m * 16 + fr, t = t0 + r;
          const int mp = m > 0 ? m - 1 : 0, mn = m < 3 ? m + 1 : 3;
          f32x4 o;
#pragma unroll
          for (int j = 0; j < 4; ++j) {
            const float gc = acc[ai][0][m][q][j], vc = acc[ai][1][m][q][j];
            const float gp = dpp_ror1(fr == 15 ? acc[ai][0][mp][q][j] : gc), gn = dpp_ror15(fr == 0 ? acc[ai][0][mn][q][j] : gc);
            const float vp = dpp_ror1(fr == 15 ? acc[ai][1][mp][q][j] : vc), vn = dpp_ror15(fr == 0 ? acc[ai][1][mn][q][j] : vc);
            const float gg = wg[0][j] * gp + wg[1][j] * gc + wg[2][j] * gn + bg[j];
            const float vv = wv[0][j] * vp + wv[1][j] * vc + wv[2][j] * vn + bv[j];
            o[j] = gg * __builtin_amdgcn_rcpf(1.f + __expf(-gg)) * vv;
          }
          if (r >= 1 && r <= 62 && t < L)
            *(u32x2*)((char*)p.act + (unsigned)(((base + t) * DFF + f0 + 4 * q) * 2)) = mk2(pack2(o[0], o[1]), pack2(o[2], o[3]));
          __builtin_amdgcn_sched_barrier(0);
        }
      }
      __builtin_amdgcn_sched_barrier(0);
    }
  }
}

DI void attn_item(const Params& p, int layer, int item, char* smem) {
  constexpr int LDK = 136, LDV = 72;
  bf16_t* sK = (bf16_t*)smem;
  bf16_t* sV = sK + 64 * LDK;
  const int tid = tidx(), lane = tid & 63, wid = tid >> 6, l15 = lane & 15, quad = lane >> 4;
  bool isctx; int b, h, qb;
  if (item < 512) { b = item >> 6; h = (item >> 4) & 3; qb = item & 15; isctx = false; }
  else { int it = item - 512; b = it >> 3; h = (it >> 1) & 3; qb = it & 1; isctx = true; }
  const float lam_init = 0.8f - 0.6f * expf(-0.3f * (float)layer);
  float lam;
  {
    const float* lp = p.da_lambda + layer * 256;
    float a = lp[lane] * lp[64 + lane], c2 = lp[128 + lane] * lp[192 + lane];
    a = wave_sum(a); c2 = wave_sum(c2);
    lam = expf(a) - expf(c2) + lam_init;
  }
  const int qrow = (isctx ? NLAT + b * CTXL : b * SEQ) + qb * 128 + wid * 16 + l15;
  bf16x8 qf[2][2];
#pragma unroll
  for (int m = 0; m < 2; ++m)
#pragma unroll
    for (int kk = 0; kk < 2; ++kk) qf[m][kk] = *(const bf16x8*)(p.P + (size_t)qrow * PW + PC_Q + h * 128 + m * 64 + kk * 32 + quad * 8);
  const int ntile = isctx ? 4 : 36;
  const int k0_ = tid >> 4, kch = tid & 15;
  const int kpi0 = ((k0_ >> 2) & 1) * 16 + ((k0_ >> 3) & 3) * 4 + (k0_ & 3);
  const int kldsoff0 = kpi0 * LDK + kch * 8;
#define KLDS(i) (kldsoff0 + (i) * 32 * LDK)
  const long kgoff0 = (long)k0_ * PW + PC_K + h * 128 + kch * 8;
  const long kgstep = (long)32 * PW;
  const int dv0_ = tid >> 3, c8_ = tid & 7;
  const int vldsoff0 = dv0_ * LDV + c8_ * 8;
  const long vgoff0 = ((long)((b * 4 + h) * 128 + dv0_)) * NKEY + c8_ * 8;
  const long vgstep = (long)64 * NKEY;
  f32x4 oacc[2][8];
#pragma unroll
  for (int m = 0; m < 2; ++m)
#pragma unroll
    for (int t = 0; t < 8; ++t) oacc[m][t] = (f32x4){0.f, 0.f, 0.f, 0.f};
  float mrun0 = -1e30f, mrun1 = -1e30f, lsum0 = 0.f, lsum1 = 0.f;
  u32x4 rk[2], rv[2];
  {
    const bf16_t* kbase = p.P + (size_t)(NLAT + b * CTXL) * PW;
#pragma unroll
    for (int i = 0; i < 2; ++i) { rk[i] = *(const u32x4*)(kbase + kgoff0 + i * kgstep); rv[i] = *(const u32x4*)(p.Vt + vgoff0 + i * vgstep); }
  }
  constexpr int KBUF = 64 * LDK, VBUF = 128 * LDV;
  bf16_t* const sK0 = sK;
  bf16_t* const sV0 = sK + 2 * KBUF;
  const bool late = wid >= 4;
  bf16x8 pf[2][2];
#pragma unroll
  for (int m = 0; m < 2; ++m)
#pragma unroll
    for (int s_ = 0; s_ < 2; ++s_) pf[m][s_] = (bf16x8){0, 0, 0, 0, 0, 0, 0, 0};
  auto pv = [&](const bf16_t* sVx) {
#pragma unroll
    for (int s_ = 0; s_ < 2; ++s_)
#pragma unroll
      for (int t = 0; t < 8; ++t) {
        if ((t & 3) == 0) __builtin_amdgcn_sched_barrier(0);
        bf16x8 a = *(const bf16x8*)(sVx + (t * 16 + l15) * LDV + s_ * 32 + quad * 8);
        oacc[0][t] = __builtin_amdgcn_mfma_f32_16x16x32_bf16(a, pf[0][s_], oacc[0][t], 0, 0, 0);
        oacc[1][t] = __builtin_amdgcn_mfma_f32_16x16x32_bf16(a, pf[1][s_], oacc[1][t], 0, 0, 0);
      }
  };
  __syncthreads();
#pragma unroll
  for (int i = 0; i < 2; ++i) { *(u32x4*)(sK0 + KLDS(i)) = rk[i]; *(u32x4*)(sV0 + vldsoff0 + i * 64 * LDV) = rv[i]; }
  __syncthreads();
  for (int kt = 0; kt < ntile; ++kt) {
    sK = sK0 + (kt & 1) * KBUF;
    sV = sV0 + (kt % 3) * VBUF;
    if (kt + 1 < ntile) {
      int k2 = kt + 1;
      const bf16_t* kbase = (k2 < 4) ? p.P + (size_t)(NLAT + b * CTXL + k2 * 64) * PW : p.P + (size_t)(b * SEQ + (k2 - 4) * 64) * PW;
#pragma unroll
      for (int i = 0; i < 2; ++i) { rk[i] = *(const u32x4*)(kbase + kgoff0 + i * kgstep); rv[i] = *(const u32x4*)(p.Vt + vgoff0 + i * vgstep + k2 * 64); }
    }
    if (late && kt > 0) pv(sV0 + ((kt + 2) % 3) * VBUF);
    f32x4 sacc[2][4];
    __builtin_amdgcn_sched_barrier(0);
#pragma unroll
    for (int m = 0; m < 2; ++m)
#pragma unroll
      for (int tau = 0; tau < 4; ++tau) {
        f32x4 s = (f32x4){0.f, 0.f, 0.f, 0.f};
#pragma unroll
        for (int kk = 0; kk < 2; ++kk) {
          bf16x8 a = *(const bf16x8*)(sK + (tau * 16 + l15) * LDK + m * 64 + kk * 32 + quad * 8);
          s = __builtin_amdgcn_mfma_f32_16x16x32_bf16(a, qf[m][kk], s, 0, 0, 0);
        }
        sacc[m][tau] = s;
      }
    __builtin_amdgcn_sched_barrier(0);
#pragma unroll
    for (int m = 0; m < 2; ++m) {
      float mx = sacc[m][0][0];
#pragma unroll
      for (int tau = 0; tau < 4; ++tau)
#pragma unroll
        for (int j = 0; j < 4; ++j) mx = fmaxf(mx, sacc[m][tau][j]);
      {
        const auto r16 = __builtin_amdgcn_permlane16_swap(__float_as_uint(mx), __float_as_uint(mx), false, false);
        mx = fmaxf(__uint_as_float(r16[0]), __uint_as_float(r16[1]));
        const auto r32 = __builtin_amdgcn_permlane32_swap(__float_as_uint(mx), __float_as_uint(mx), false, false);
        mx = fmaxf(__uint_as_float(r32[0]), __uint_as_float(r32[1]));
      }
      const float mold = (m == 0) ? mrun0 : mrun1;
      const bool moved = __builtin_amdgcn_ballot_w64(mx > mold + 8.f) != 0ull;
      const float mnew = moved ? fmaxf(mold, mx) : mold;
      if (m == 0) mrun0 = mnew; else mrun1 = mnew;
      float ps = 0.f;
      u32x4 u0, u1;
      {
        float e0 = __builtin_amdgcn_exp2f(sacc[m][0][0] - mnew), e1 = __builtin_amdgcn_exp2f(sacc[m][0][1] - mnew), e2 = __builtin_amdgcn_exp2f(sacc[m][0][2] - mnew), e3 = __builtin_amdgcn_exp2f(sacc[m][0][3] - mnew);
        ps += (e0 + e1) + (e2 + e3); u0.x = pack2(e0, e1); u0.y = pack2(e2, e3);
      }
      {
        float e0 = __builtin_amdgcn_exp2f(sacc[m][1][0] - mnew), e1 = __builtin_amdgcn_exp2f(sacc[m][1][1] - mnew), e2 = __builtin_amdgcn_exp2f(sacc[m][1][2] - mnew), e3 = __builtin_amdgcn_exp2f(sacc[m][1][3] - mnew);
        ps += (e0 + e1) + (e2 + e3); u0.z = pack2(e0, e1); u0.w = pack2(e2, e3);
      }
      {
        float e0 = __builtin_amdgcn_exp2f(sacc[m][2][0] - mnew), e1 = __builtin_amdgcn_exp2f(sacc[m][2][1] - mnew), e2 = __builtin_amdgcn_exp2f(sacc[m][2][2] - mnew), e3 = __builtin_amdgcn_exp2f(sacc[m][2][3] - mnew);
        ps += (e0 + e1) + (e2 + e3); u1.x = pack2(e0, e1); u1.y = pack2(e2, e3);
      }
      {
        float e0 = __builtin_amdgcn_exp2f(sacc[m][3][0] - mnew), e1 = __builtin_amdgcn_exp2f(sacc[m][3][1] - mnew), e2 = __builtin_amdgcn_exp2f(sacc[m][3][2] - mnew), e3 = __builtin_amdgcn_exp2f(sacc[m][3][3] - mnew);
        ps += (e0 + e1) + (e2 + e3); u1.z = pack2(e0, e1); u1.w = pack2(e2, e3);
      }
      if (moved) {
        const float alpha = __builtin_amdgcn_exp2f(mold - mnew);
        if (m == 0) lsum0 *= alpha; else lsum1 *= alpha;
#pragma unroll
        for (int t = 0; t < 8; ++t) { oacc[m][t][0] *= alpha; oacc[m][t][1] *= alpha; oacc[m][t][2] *= alpha; oacc[m][t][3] *= alpha; }
      }
      if (m == 0) lsum0 += ps; else lsum1 += ps;
      pf[m][0] = __builtin_bit_cast(bf16x8, u0);
      pf[m][1] = __builtin_bit_cast(bf16x8, u1);
    }
    __builtin_amdgcn_sched_barrier(0);
    if (!late) pv(sV);
    if (kt + 1 < ntile) {
      bf16_t* nK = sK0 + ((kt + 1) & 1) * KBUF;
      bf16_t* nV = sV0 + ((kt + 1) % 3) * VBUF;
#pragma unroll
      for (int i = 0; i < 2; ++i) { *(u32x4*)(nK + KLDS(i)) = rk[i]; *(u32x4*)(nV + vldsoff0 + i * 64 * LDV) = rv[i]; }
    }
    __syncthreads();
  }
  if (late) pv(sV0 + ((ntile - 1) % 3) * VBUF);
  float l0 = lsum0, l1 = lsum1;
  l0 += __shfl_xor(l0, 16); l0 += __shfl_xor(l0, 32);
  l1 += __shfl_xor(l1, 16); l1 += __shfl_xor(l1, 32);
  const float i0 = 1.f / l0, i1 = lam / l1;
  float ss = 0.f;
#pragma unroll
  for (int t = 0; t < 8; ++t)
#pragma unroll
    for (int j = 0; j < 4; ++j) {
      float o = oacc[0][t][j] * i0 - oacc[1][t][j] * i1;
      oacc[0][t][j] = o;
      ss += o * o;
    }
  ss += __shfl_xor(ss, 16); ss += __shfl_xor(ss, 32);
  const float rstd = rsqrtf(ss * (1.f / 128.f) + 1e-6f) * (1.f - lam_init);
  const float* sg = p.da_subln_g + layer * 128;
#pragma unroll
  for (int t = 0; t < 8; ++t) {
    int dv = t * 16 + quad * 4;
    float4 g = *(const float4*)(sg + dv);
    *(u32x2*)(p.Abuf + (size_t)qrow * D + h * 128 + dv) =
        mk2(pack2(oacc[0][t][0] * rstd * g.x, oacc[0][t][1] * rstd * g.y), pack2(oacc[0][t][2] * rstd * g.z, oacc[0][t][3] * rstd * g.w));
  }
}

DI float red16(float v) {
  v += __int_as_float(__builtin_amdgcn_update_dpp(0, __float_as_int(v), 0xB1, 0xF, 0xF, true));
  v += __int_as_float(__builtin_amdgcn_update_dpp(0, __float_as_int(v), 0x4E, 0xF, 0xF, true));
  v += __int_as_float(__builtin_amdgcn_update_dpp(0, __float_as_int(v), 0x141, 0xF, 0xF, true));
  v += __int_as_float(__builtin_amdgcn_update_dpp(0, __float_as_int(v), 0x140, 0xF, 0xF, true));
  return v;
}
DI float red8(float v) {
  v += __int_as_float(__builtin_amdgcn_update_dpp(0, __float_as_int(v), 0xB1, 0xF, 0xF, true));
  v += __int_as_float(__builtin_amdgcn_update_dpp(0, __float_as_int(v), 0x4E, 0xF, 0xF, true));
  v += __int_as_float(__builtin_amdgcn_update_dpp(0, __float_as_int(v), 0x141, 0xF, 0xF, true));
  return v;
}
constexpr int SC2_Q = 0, SC2_K = 2048, SC2_V = 4096, SC2_A = 6144, SC2_O = 6272, SC2_BUF = 8320;
template <int MX>
DI void scan_item(const Params& p, int layer, int dir, int b, int h, float* sm) {
  const int tfull = tidx();
  const bool stager = tfull >= 256;
  const int tid = tfull & 255;
  const int e = tid >> 2, part = tid & 3;
  const int pl = tid >> 3, p8 = tid & 7;
  const int slot_w = dir == 0 ? pl : 31 - pl;
  f32x2 s2[8];
#pragma unroll
  for (int d = 0; d < 8; ++d) s2[d] = (f32x2){0.f, 0.f};
  float lbf[8], oml[8];
  float gA = 0.f, gdt = 0.f;
  if (MX == 0) {
#pragma unroll
    for (int d = 0; d < 8; ++d) {
      float lb = 0.f;
      if (layer == 1) {
        int ci = dir * 256 + h * 64 + p8 * 8 + d;
        float l0 = p.hg_lb_logits[ci], l1 = p.hg_lb_logits[512 + ci];
        lb = 1.f / (1.f + expf(l0 - l1));
      }
      lbf[d] = fmaxf(lb, 1e-30f);
      oml[d] = 1.f - lb;
    }
  } else {
    gA = expf(p.gd_a_log[layer * 8 + dir * 4 + h]);
    gdt = p.gd_dt_bias[layer * 8 + dir * 4 + h];
  }
  const float* cw = p.gd_conv_w + (size_t)layer * 3 * 768;
  u32x4 rq[3], rk[3], rv[3];
  float ra_ = 0.f, rb_ = 0.f;
  const u32x4 z4 = {0u, 0u, 0u, 0u};
#pragma unroll
  for (int j = 0; j < 3; ++j) { rq[j] = z4; rk[j] = z4; rv[j] = z4; }

#define SCAN_CHUNK_GEOM(c)                                                   \
  const int seg_ = (c) < 8 ? 0 : 1;                                          \
  const int L_ = seg_ == 0 ? CTXL : SEQ;                                     \
  const int rowbase_ = seg_ == 0 ? NLAT + b * CTXL : b * SEQ;                \
  const int ci_ = seg_ == 0 ? (c) : (c) - 8;                                 \
  const int p0_ = dir == 0 ? ci_ * 32 : L_ - 32 * (ci_ + 1);

  auto load_raw = [&](int c) {
    SCAN_CHUNK_GEOM(c)
    const int pos = p0_ + pl;
    const bf16_t* prow = p.P + (size_t)(rowbase_ + pos) * PW;
    if (MX == 0) {
      rq[0] = *(const u32x4*)(prow + PC_HQ + h * 64 + p8 * 8);
      rk[0] = *(const u32x4*)(prow + PC_HF + dir * 256 + h * 64 + p8 * 8);
      rv[0] = *(const u32x4*)(prow + PC_HI + h * 64 + p8 * 8);
    } else {
#pragma unroll
      for (int j = 0; j < 3; ++j) {
        const int pp = pos + j - 1;
        const bool ok = (pp >= 0 && pp < L_);
        const bf16_t* pr = p.P + (size_t)(rowbase_ + pp) * PW + PC_GQKV + h * 64 + p8 * 8;
        rq[j] = ok ? *(const u32x4*)(pr) : z4;
        rk[j] = ok ? *(const u32x4*)(pr + 256) : z4;
        rv[j] = ok ? *(const u32x4*)(pr + 512) : z4;
      }
      if (p8 == 0) { ra_ = bf2f(prow[PC_GA + dir * 4 + h]); rb_ = bf2f(prow[PC_GB + dir * 4 + h]); }
    }
  };
  auto compute_store = [&](float* buf) {
    float* sq = buf + SC2_Q + slot_w * 64 + p8 * 8;
    float* sk = buf + SC2_K + slot_w * 64 + p8 * 8;
    float* sv = buf + SC2_V + slot_w * 64 + p8 * 8;
    if (MX == 0) {
      float qv[8], fv[8], iv[8];
      unpack8(rq[0], qv); unpack8(rk[0], fv); unpack8(rv[0], iv);
      f32x4 o0, o1, f0, f1;
#pragma unroll
      for (int d = 0; d < 4; ++d) {
        o0[d] = qv[d] * __builtin_amdgcn_rcpf(1.f + __expf(-qv[d])); o1[d] = qv[4 + d] * __builtin_amdgcn_rcpf(1.f + __expf(-qv[4 + d]));
        f0[d] = lbf[d] + oml[d] * __builtin_amdgcn_rcpf(1.f + __expf(-fv[d])); f1[d] = lbf[4 + d] + oml[4 + d] * __builtin_amdgcn_rcpf(1.f + __expf(-fv[4 + d]));
      }
      *(f32x4*)(sq) = o0; *(f32x4*)(sq + 4) = o1;
      *(f32x4*)(sk) = f0; *(f32x4*)(sk + 4) = f1;
      const f32x4 v0 = {iv[0], iv[1], iv[2], iv[3]}, v1 = {iv[4], iv[5], iv[6], iv[7]};
      *(f32x4*)(sv) = v0; *(f32x4*)(sv + 4) = v1;
    } else {
      float yq[8], yk[8], yv[8];
#pragma unroll
      for (int d = 0; d < 8; ++d) { yq[d] = 0.f; yk[d] = 0.f; yv[d] = 0.f; }
#pragma unroll
      for (int j = 0; j < 3; ++j) {
        float xq[8], xk[8], xv[8];
        unpack8(rq[j], xq); unpack8(rk[j], xk); unpack8(rv[j], xv);
        const float* cq = cw + j * 768 + h * 64 + p8 * 8;
        const f32x4 wq0 = *(const f32x4*)(cq), wq1 = *(const f32x4*)(cq + 4);
        const f32x4 wk0 = *(const f32x4*)(cq + 256), wk1 = *(const f32x4*)(cq + 260);
        const f32x4 wv0 = *(const f32x4*)(cq + 512), wv1 = *(const f32x4*)(cq + 516);
#pragma unroll
        for (int d = 0; d < 4; ++d) {
          yq[d] += xq[d] * wq0[d]; yq[4 + d] += xq[4 + d] * wq1[d];
          yk[d] += xk[d] * wk0[d]; yk[4 + d] += xk[4 + d] * wk1[d];
          yv[d] += xv[d] * wv0[d]; yv[4 + d] += xv[4 + d] * wv1[d];
        }
      }
      float sq2 = 0.f, sk2 = 0.f;
#pragma unroll
      for (int d = 0; d < 8; ++d) {
        yq[d] = yq[d] * __builtin_amdgcn_rcpf(1.f + __expf(-yq[d]));
        yk[d] = yk[d] * __builtin_amdgcn_rcpf(1.f + __expf(-yk[d]));
        yv[d] = yv[d] * __builtin_amdgcn_rcpf(1.f + __expf(-yv[d]));
        sq2 += yq[d] * yq[d]; sk2 += yk[d] * yk[d];
      }
      sq2 = red8(sq2); sk2 = red8(sk2);
      const float rqn = rsqrtf(sq2 + 1e-6f) * 0.125f, rkn = rsqrtf(sk2 + 1e-6f);
      float qk = 0.f;
      f32x4 o0, o1, k0, k1;
#pragma unroll
      for (int d = 0; d < 4; ++d) {
        o0[d] = yq[d] * rqn; o1[d] = yq[4 + d] * rqn; k0[d] = yk[d] * rkn; k1[d] = yk[4 + d] * rkn;
        qk += o0[d] * k0[d] + o1[d] * k1[d];
      }
      qk = red8(qk);
      *(f32x4*)(sq) = o0; *(f32x4*)(sq + 4) = o1;
      *(f32x4*)(sk) = k0; *(f32x4*)(sk + 4) = k1;
      const f32x4 v0 = {yv[0], yv[1], yv[2], yv[3]}, v1 = {yv[4], yv[5], yv[6], yv[7]};
      *(f32x4*)(sv) = v0; *(f32x4*)(sv + 4) = v1;
      if (p8 == 0) {
        const float xx = ra_ + gdt;
        const float y = __expf(xx);
        const float sp = xx > 15.f ? xx : (y < 1e-3f ? y * (1.f - 0.5f * y) : __logf(1.f + y));
        const f32x4 rec = {__expf(-gA * sp), __builtin_amdgcn_rcpf(1.f + __expf(-rb_)), qk, 0.f};
        *(f32x4*)(buf + SC2_A + slot_w * 4) = rec;
      }
    }
  };
  auto write_out = [&](int c) {
    SCAN_CHUNK_GEOM(c)
    const float* so = sm + (c & 1) * SC2_BUF + SC2_O + slot_w * 64 + p8 * 8;
    const f32x4 a0 = *(const f32x4*)so, a1 = *(const f32x4*)(so + 4);
    bf16_t* dst = p.raw + ((size_t)((MX * 2 + dir) * NROW + rowbase_ + p0_ + pl)) * 256 + h * 64 + p8 * 8;
    *(u32x4*)dst = mk4(pack2(a0[0], a0[1]), pack2(a0[2], a0[3]), pack2(a1[0], a1[1]), pack2(a1[2], a1[3]));
  };

  constexpr int NCH = 8 + 64;
  __syncthreads();
  if (stager) { load_raw(0); compute_store(sm); }
  __syncthreads();
  if (!stager) __builtin_amdgcn_s_setprio(3);
  for (int c = 0; c < NCH; ++c) {
    if (stager) {
      if (c + 1 < NCH) load_raw(c + 1);
      if (c > 0) write_out(c - 1);
      if (c + 1 < NCH) compute_store(sm + ((c + 1) & 1) * SC2_BUF);
    } else {
      const float* buf = sm + (c & 1) * SC2_BUF;
      const float* sq = buf + SC2_Q + part * 16;
      const float* sk = buf + SC2_K + part * 16;
      const float* sv = buf + SC2_V + e;
      const float* sa = buf + SC2_A;
      float* so = sm + (c & 1) * SC2_BUF + SC2_O + e;
      f32x4 qn[4], kn[4];
      float vnx;
      f32x4 recn = {0.f, 0.f, 0.f, 0.f};
#pragma unroll
      for (int u = 0; u < 4; ++u) { qn[u] = *(const f32x4*)(sq + 4 * u); kn[u] = *(const f32x4*)(sk + 4 * u); }
      vnx = sv[0];
      if (MX == 1) recn = *(const f32x4*)(sa);
#pragma unroll
      for (int i = 0; i < 32; ++i) {
        f32x4 q[4], k[4];
#pragma unroll
        for (int u = 0; u < 4; ++u) { q[u] = qn[u]; k[u] = kn[u]; }
        const float vv = vnx;
        const f32x4 rec = recn;
        const int il = (i < 31) ? i + 1 : i;
#pragma unroll
        for (int u = 0; u < 4; ++u) { qn[u] = *(const f32x4*)(sq + il * 64 + 4 * u); kn[u] = *(const f32x4*)(sk + il * 64 + 4 * u); }
        vnx = sv[il * 64];
        if (MX == 1) recn = *(const f32x4*)(sa + il * 4);
        float o;
        if (MX == 0) {
          const f32x2 vv2 = {vv, vv};
          f32x2 acc2 = {0.f, 0.f};
#pragma unroll
          for (int u = 0; u < 4; ++u) {
            const f32x2 klo = {k[u][0], k[u][1]}, khi = {k[u][2], k[u][3]};
            const f32x2 qlo = {q[u][0], q[u][1]}, qhi = {q[u][2], q[u][3]};
            s2[2 * u] = vv2 + klo * (s2[2 * u] - vv2);
            s2[2 * u + 1] = vv2 + khi * (s2[2 * u + 1] - vv2);
            acc2 += s2[2 * u] * qlo;
            acc2 += s2[2 * u + 1] * qhi;
          }
          o = quad_sum(acc2[0] + acc2[1]);
        } else {
          const float al = rec[0], be = rec[1], qk = rec[2];
          f32x2 ks2 = {0.f, 0.f}, qs2 = {0.f, 0.f};
#pragma unroll
          for (int u = 0; u < 4; ++u) {
            const f32x2 klo = {k[u][0], k[u][1]}, khi = {k[u][2], k[u][3]};
            const f32x2 qlo = {q[u][0], q[u][1]}, qhi = {q[u][2], q[u][3]};
            ks2 += klo * s2[2 * u]; ks2 += khi * s2[2 * u + 1];
            qs2 += qlo * s2[2 * u]; qs2 += qhi * s2[2 * u + 1];
          }
          const float ks = quad_sum(ks2[0] + ks2[1]), qs = quad_sum(qs2[0] + qs2[1]);
          const float vn = be * (vv - al * ks);
          const f32x2 al2 = {al, al}, vn2 = {vn, vn};
#pragma unroll
          for (int u = 0; u < 4; ++u) {
            const f32x2 klo = {k[u][0], k[u][1]}, khi = {k[u][2], k[u][3]};
            s2[2 * u] = al2 * s2[2 * u] + klo * vn2;
            s2[2 * u + 1] = al2 * s2[2 * u + 1] + khi * vn2;
          }
          o = al * qs + qk * vn;
        }
        so[i * 64] = o;
      }
    }
    __syncthreads();
  }
  __builtin_amdgcn_s_setprio(0);
  if (stager) write_out(NCH - 1);
}

constexpr int GD_QK = 4224;
constexpr int GD_V = 3 * GD_QK;
constexpr int GD_VNT = GD_V + 2 * 2048;
constexpr int GD_S0 = GD_VNT + 2 * 2048;
constexpr int GD_GC = GD_S0 + 2 * 2048;
constexpr int GD_QKB = GD_GC + 128;
DI bf16x8 cvt8(const f32x4 a, const f32x4 b) {
  const u32x4 u = mk4(pack2(a[0], a[1]), pack2(a[2], a[3]), pack2(b[0], b[1]), pack2(b[2], b[3]));
  return __builtin_bit_cast(bf16x8, u);
}
DI void scan_item_gdn(const Params& p, int layer, int dir, int b, int h, float* sm) {
  const int tfull = tidx();
  const bool stager = tfull >= 256;
  const int tid = tfull & 255;
  const int e = tid >> 2, part = tid & 3;
  const int pl = tid >> 3, p8 = tid & 7;
  const int slot_w = dir == 0 ? pl : 31 - pl;
  const int sw = tid >> 6, lane = tid & 63, l15 = lane & 15, g = lane >> 4;
  f32x2 s2[8];
#pragma unroll
  for (int d = 0; d < 8; ++d) s2[d] = (f32x2){0.f, 0.f};
  const float gA = expf(p.gd_a_log[layer * 8 + dir * 4 + h]);
  const float gdt = p.gd_dt_bias[layer * 8 + dir * 4 + h];
  const float* cw = p.gd_conv_w + (size_t)layer * 3 * 768;
  u32x4 rq[3], rk[3], rv[3];
  float ra_ = 0.f, rb_ = 0.f;
  const u32x4 z4 = {0u, 0u, 0u, 0u};
#pragma unroll
  for (int j = 0; j < 3; ++j) { rq[j] = z4; rk[j] = z4; rv[j] = z4; }

#define GDN_CHUNK_GEOM(c)                                                    \
  const int seg_ = (c) < 8 ? 0 : 1;                                          \
  const int L_ = seg_ == 0 ? CTXL : SEQ;                                     \
  const int rowbase_ = seg_ == 0 ? NLAT + b * CTXL : b * SEQ;                \
  const int ci_ = seg_ == 0 ? (c) : (c) - 8;                                 \
  const int p0_ = dir == 0 ? ci_ * 32 : L_ - 32 * (ci_ + 1);

  auto load_raw = [&](int c) {
    GDN_CHUNK_GEOM(c)
    const int pos = p0_ + pl;
    const bf16_t* prow = p.P + (size_t)(rowbase_ + pos) * PW;
#pragma unroll
    for (int j = 0; j < 3; ++j) {
      const int pp = pos + j - 1;
      const bool ok = (pp >= 0 && pp < L_);
      const bf16_t* pr = p.P + (size_t)(rowbase_ + pp) * PW + PC_GQKV + h * 64 + p8 * 8;
      rq[j] = ok ? *(const u32x4*)(pr) : z4;
      rk[j] = ok ? *(const u32x4*)(pr + 256) : z4;
      rv[j] = ok ? *(const u32x4*)(pr + 512) : z4;
    }
    if (p8 == 0) { ra_ = bf2f(prow[PC_GA + dir * 4 + h]); rb_ = bf2f(prow[PC_GB + dir * 4 + h]); }
  };
  auto compute_store = [&](int c) {
    float* qk = sm + (c % 3) * GD_QK;
    float* sq = qk + slot_w * 64 + p8 * 8;
    float* sk = qk + 2048 + slot_w * 64 + p8 * 8;
    float* sv = sm + GD_V + (c & 1) * 2048 + slot_w * 64 + p8 * 8;
    float yq[8], yk[8], yv[8];
#pragma unroll
    for (int d = 0; d < 8; ++d) { yq[d] = 0.f; yk[d] = 0.f; yv[d] = 0.f; }
#pragma unroll
    for (int j = 0; j < 3; ++j) {
      float xq[8], xk[8], xv[8];
      unpack8(rq[j], xq); unpack8(rk[j], xk); unpack8(rv[j], xv);
      const float* cq = cw + j * 768 + h * 64 + p8 * 8;
      const f32x4 wq0 = *(const f32x4*)(cq), wq1 = *(const f32x4*)(cq + 4);
      const f32x4 wk0 = *(const f32x4*)(cq + 256), wk1 = *(const f32x4*)(cq + 260);
      const f32x4 wv0 = *(const f32x4*)(cq + 512), wv1 = *(const f32x4*)(cq + 516);
#pragma unroll
      for (int d = 0; d < 4; ++d) {
        yq[d] += xq[d] * wq0[d]; yq[4 + d] += xq[4 + d] * wq1[d];
        yk[d] += xk[d] * wk0[d]; yk[4 + d] += xk[4 + d] * wk1[d];
        yv[d] += xv[d] * wv0[d]; yv[4 + d] += xv[4 + d] * wv1[d];
      }
    }
    float sq2 = 0.f, sk2 = 0.f;
#pragma unroll
    for (int d = 0; d < 8; ++d) {
      yq[d] = yq[d] * __builtin_amdgcn_rcpf(1.f + __expf(-yq[d]));
      yk[d] = yk[d] * __builtin_amdgcn_rcpf(1.f + __expf(-yk[d]));
      yv[d] = yv[d] * __builtin_amdgcn_rcpf(1.f + __expf(-yv[d]));
      sq2 += yq[d] * yq[d]; sk2 += yk[d] * yk[d];
    }
    sq2 = red8(sq2); sk2 = red8(sk2);
    const float rqn = rsqrtf(sq2 + 1e-6f) * 0.125f, rkn = rsqrtf(sk2 + 1e-6f);
    f32x4 o0, o1, k0, k1;
#pragma unroll
    for (int d = 0; d < 4; ++d) { o0[d] = yq[d] * rqn; o1[d] = yq[4 + d] * rqn; k0[d] = yk[d] * rkn; k1[d] = yk[4 + d] * rkn; }
    *(f32x4*)(sq) = o0; *(f32x4*)(sq + 4) = o1;
    *(f32x4*)(sk) = k0; *(f32x4*)(sk + 4) = k1;
    {
      bf16_t* qkb = (bf16_t*)(sm + GD_QKB + (c % 3) * 2048);
      *(bf16x8*)(qkb + slot_w * 64 + p8 * 8) = cvt8(o0, o1);
      *(bf16x8*)(qkb + 2048 + slot_w * 64 + p8 * 8) = cvt8(k0, k1);
    }
    const f32x4 v0 = {yv[0], yv[1], yv[2], yv[3]}, v1 = {yv[4], yv[5], yv[6], yv[7]};
    *(f32x4*)(sv) = v0; *(f32x4*)(sv + 4) = v1;
    if (p8 == 0) {
      const float xx = ra_ + gdt;
      const float y = __expf(xx);
      const float sp = xx > 15.f ? xx : (y < 1e-3f ? y * (1.f - 0.5f * y) : __logf(1.f + y));
      const float la = fmaxf(-gA * sp * 1.4426950408889634f, -115.f);
      const f32x4 rec = {__expf(-gA * sp), __builtin_amdgcn_rcpf(1.f + __expf(-rb_)), la, 0.f};
      *(f32x4*)(qk + 4096 + slot_w * 4) = rec;
    }
  };
  auto output = [&](int c) {
    GDN_CHUNK_GEOM(c)
    const float* qk = sm + (c % 3) * GD_QK;
    const float* sq = qk;
    const float* sk = qk + 2048;
    const float* rec = qk + 4096;
    const float* vnt = sm + GD_VNT + (c & 1) * 2048;
    const bf16_t* s0t = (const bf16_t*)(sm + GD_S0 + (c & 1) * 2048);
    float* gcs = sm + GD_GC + sw * 32;
    {
      float x = (lane < 32) ? rec[lane * 4 + 2] : 0.f;
#pragma unroll
      for (int off = 1; off < 32; off <<= 1) { const float t = __shfl_up(x, off); if (lane >= off) x += t; }
      if (lane < 32) gcs[lane] = x;
    }
    const float gct0 = gcs[l15], gct1 = gcs[16 + l15];
    const float eg0 = __builtin_amdgcn_exp2f(gct0), eg1 = __builtin_amdgcn_exp2f(gct1);
    const bf16_t* qb = (const bf16_t*)(sm + GD_QKB + (c % 3) * 2048);
    const bf16_t* kb = qb + 2048;
    bf16x8 qf[2][2];
#pragma unroll
    for (int n = 0; n < 2; ++n)
#pragma unroll
      for (int kk = 0; kk < 2; ++kk) qf[n][kk] = *(const bf16x8*)(qb + (16 * n + l15) * 64 + 32 * kk + 8 * g);
    f32x4 acc[2];
#pragma unroll
    for (int n = 0; n < 2; ++n) acc[n] = (f32x4){0.f, 0.f, 0.f, 0.f};
#pragma unroll
    for (int kk = 0; kk < 2; ++kk) {
      const bf16x8 a = *(const bf16x8*)(s0t + (16 * sw + l15) * 64 + 32 * kk + 8 * g);
      acc[0] = __builtin_amdgcn_mfma_f32_16x16x32_bf16(a, qf[0][kk], acc[0], 0, 0, 0);
      acc[1] = __builtin_amdgcn_mfma_f32_16x16x32_bf16(a, qf[1][kk], acc[1], 0, 0, 0);
    }
    acc[0] *= eg0; acc[1] *= eg1;
    f32x4 wt[2][2];
#pragma unroll
    for (int m = 0; m < 2; ++m)
#pragma unroll
      for (int n = 0; n < 2; ++n) wt[m][n] = (f32x4){0.f, 0.f, 0.f, 0.f};
#pragma unroll
    for (int m = 0; m < 2; ++m)
#pragma unroll
      for (int kk = 0; kk < 2; ++kk) {
        const bf16x8 a = *(const bf16x8*)(kb + (16 * m + l15) * 64 + 32 * kk + 8 * g);
        if (m == 0) wt[0][0] = __builtin_amdgcn_mfma_f32_16x16x32_bf16(a, qf[0][kk], wt[0][0], 0, 0, 0);
        wt[m][1] = __builtin_amdgcn_mfma_f32_16x16x32_bf16(a, qf[1][kk], wt[m][1], 0, 0, 0);
      }
#pragma unroll
    for (int m = 0; m < 2; ++m) {
      const f32x4 gs = *(const f32x4*)(gcs + 16 * m + 4 * g);
#pragma unroll
      for (int n = 0; n < 2; ++n) {
        if (m == 1 && n == 0) continue;
        const float gt = n == 0 ? gct0 : gct1;
        const int t = 16 * n + l15;
#pragma unroll
        for (int j = 0; j < 4; ++j) {
          const int s_ = 16 * m + 4 * g + j;
          wt[m][n][j] = (s_ <= t) ? wt[m][n][j] * __builtin_amdgcn_exp2f(gt - gs[j]) : 0.f;
        }
      }
    }
    {
      const float* vsrc = vnt + (16 * sw + l15) * 32 + 4 * g;
      const bf16x8 a = cvt8(*(const f32x4*)vsrc, *(const f32x4*)(vsrc + 16));
#pragma unroll
      for (int n = 0; n < 2; ++n) {
        const bf16x8 bw = cvt8(wt[0][n], wt[1][n]);
        acc[n] = __builtin_amdgcn_mfma_f32_16x16x32_bf16(a, bw, acc[n], 0, 0, 0);
      }
    }
#pragma unroll
    for (int n = 0; n < 2; ++n) {
      const int t = 16 * n + l15;
      const int pos = p0_ + (dir == 0 ? t : 31 - t);
      bf16_t* dst = p.raw + ((size_t)((1 * 2 + dir) * NROW + rowbase_ + pos)) * 256 + h * 64 + 16 * sw + 4 * g;
      *(u32x2*)dst = mk2(pack2(acc[n][0], acc[n][1]), pack2(acc[n][2], acc[n][3]));
    }
  };

  constexpr int NCH = 8 + 64;
  __syncthreads();
  if (stager) { load_raw(0); compute_store(0); }
  __syncthreads();
  if (!stager) __builtin_amdgcn_s_setprio(3);
  for (int c = 0; c < NCH; ++c) {
    if (stager) {
      if (c + 1 < NCH) load_raw(c + 1);
      if (c > 0) output(c - 1);
      if (c + 1 < NCH) compute_store(c + 1);
    } else {
      const float* qk = sm + (c % 3) * GD_QK;
      const float* sq = qk + part * 16;
      const float* sk = qk + 2048 + part * 16;
      const float* sa = qk + 4096;
      const float* sv = sm + GD_V + (c & 1) * 2048 + e;
      float* vnt = sm + GD_VNT + (c & 1) * 2048 + e * 32;
      {
        bf16_t* s0 = (bf16_t*)(sm + GD_S0 + (c & 1) * 2048) + e * 64 + part * 16;
        *(u32x4*)s0 = mk4(pack2(s2[0][0], s2[0][1]), pack2(s2[1][0], s2[1][1]), pack2(s2[2][0], s2[2][1]), pack2(s2[3][0], s2[3][1]));
        *(u32x4*)(s0 + 8) = mk4(pack2(s2[4][0], s2[4][1]), pack2(s2[5][0], s2[5][1]), pack2(s2[6][0], s2[6][1]), pack2(s2[7][0], s2[7][1]));
      }
      f32x4 kn[4];
      float vnx;
      f32x4 recn;
#pragma unroll
      for (int u = 0; u < 4; ++u) kn[u] = *(const f32x4*)(sk + 4 * u);
      vnx = sv[0];
      recn = *(const f32x4*)(sa);
#pragma unroll
      for (int i = 0; i < 32; ++i) {
        f32x4 k[4];
#pragma unroll
        for (int u = 0; u < 4; ++u) k[u] = kn[u];
        const float vv = vnx;
        const f32x4 rec = recn;
        const int il = (i < 31) ? i + 1 : i;
#pragma unroll
        for (int u = 0; u < 4; ++u) kn[u] = *(const f32x4*)(sk + il * 64 + 4 * u);
        vnx = sv[il * 64];
        recn = *(const f32x4*)(sa + il * 4);
        const float al = rec[0], be = rec[1];
        f32x2 ks2 = {0.f, 0.f};
#pragma unroll
        for (int u = 0; u < 4; ++u) {
          const f32x2 klo = {k[u][0], k[u][1]}, khi = {k[u][2], k[u][3]};
          ks2 += klo * s2[2 * u]; ks2 += khi * s2[2 * u + 1];
        }
        const float ks = quad_sum(ks2[0] + ks2[1]);
        const float vn = be * (vv - al * ks);
        const f32x2 al2 = {al, al}, vn2 = {vn, vn};
#pragma unroll
        for (int u = 0; u < 4; ++u) {
          const f32x2 klo = {k[u][0], k[u][1]}, khi = {k[u][2], k[u][3]};
          s2[2 * u] = al2 * s2[2 * u] + klo * vn2;
          s2[2 * u + 1] = al2 * s2[2 * u + 1] + khi * vn2;
        }
        vnt[i] = vn;
      }
      (void)sq;
    }
    __syncthreads();
  }
  __builtin_amdgcn_s_setprio(0);
  if (stager) output(NCH - 1);
}

DI void finish_phase(const Params& p, int layer) {
  const int lane = tidx() & 63, wid = tidx() >> 6;
  const int nrows = (layer == 1) ? NLAT : NROW;
  for (int idx = bidx() * NWAVE + wid; idx < nrows * 2; idx += gridDim.x * NWAVE) {
    const int row = idx >> 1, mx = idx & 1;
    u32x2 uf = __builtin_nontemporal_load((const u32x2*)(p.raw + ((size_t)((mx * 2 + 0) * NROW + row)) * 256 + lane * 4));
    u32x2 ub = __builtin_nontemporal_load((const u32x2*)(p.raw + ((size_t)((mx * 2 + 1) * NROW + row)) * 256 + lane * 4));
    float o[4];
    o[0] = __uint_as_float(uf.x << 16) + __uint_as_float(ub.x << 16);
    o[1] = __uint_as_float(uf.x & 0xffff0000u) + __uint_as_float(ub.x & 0xffff0000u);
    o[2] = __uint_as_float(uf.y << 16) + __uint_as_float(ub.y << 16);
    o[3] = __uint_as_float(uf.y & 0xffff0000u) + __uint_as_float(ub.y & 0xffff0000u);
    float ss = o[0] * o[0] + o[1] * o[1] + o[2] * o[2] + o[3] * o[3];
    ss += __shfl_xor(ss, 1); ss += __shfl_xor(ss, 2); ss += __shfl_xor(ss, 4); ss += __shfl_xor(ss, 8);
    const float rstd = rsqrtf(ss * (1.f / 64.f) + 1e-6f);
    u32x2 ug = *(const u32x2*)(p.P + (size_t)row * PW + (mx == 0 ? PC_HG : PC_GG) + lane * 4);
    float g[4] = {__uint_as_float(ug.x << 16), __uint_as_float(ug.x & 0xffff0000u), __uint_as_float(ug.y << 16), __uint_as_float(ug.y & 0xffff0000u)};
    const float* ng = (mx == 0 ? p.hg_norm_g : p.gd_norm_g) + layer * 64 + (lane & 15) * 4;
    float r[4];
#pragma unroll
    for (int j = 0; j < 4; ++j) r[j] = (o[j] * rstd * ng[j]) * silu_f(g[j]);
    *(u32x2*)(p.Abuf + (size_t)row * D + 512 + mx * 256 + lane * 4) = mk2(pack2(r[0], r[1]), pack2(r[2], r[3]));
  }
}

DI void run_phase(const Params& p, int ph, char* smem) {
  const int bid = bidx(), G = gridDim.x;
  LAS unsigned char* lds = (LAS unsigned char*)smem;
  if (ph == 0) {
    for (int pr = bid; pr < (WT_IN + 1) / 2; pr += G) weight_pair(p, 0, 0, WT_IN, pr, smem);
    for (int it = bid; it < 192; it += G) mod_item(p, it, (float*)smem);
    for (int it = bid; it < 64; it += G) rope_item(p, it);
    if (bid == G - 1) for (int i = tidx(); i < D / 2; i += NTHR) ((unsigned*)(p.Abuf + (size_t)NROW * D))[i] = 0u;
    return;
  }
  int layer, code;
  if (ph == 1) { layer = 0; code = 10; }
  else if (ph < 12) { layer = 0; code = ph - 2; }
  else { layer = 1; const int q = ph - 12; code = q < 5 ? q : q + 1; if (code == 9) code = 8; }
  bool do_mix = false, do_upd = false;
  const bf16_t* gA = nullptr; const bf16_t* gB = nullptr; int gK = 0, gnM = 0, gpm = 0, gG = 0, gc = 0;
  int uwhich = 0, umode = 0, ubofs = 0, unb = G;
  switch (code) {
    case 10: do_upd = true; uwhich = 0; break;
    case 0: {
      gemm_phase<EPI_P, 0>(p, layer, lds, p.Abuf, p.WinT, D, NROW / 256, INW / 256);
      gemm_phase<EPI_VT, 0>(p, layer, lds, p.WvT, p.Abuf, D, 2, NROW / 256);
      if (G == 256 && bid >= 144) for (int k = 0; k < WPRE / 112; ++k) weight_pair(p, layer, WT_IN, WT_ITEMS, (bid - 144) + k * 112, smem);
    } break;
    case 1: {
      const int nattn = (layer == 0) ? 512 + 64 : 512;
      const int wpre = (G == 256) ? WPRE : 0;
      const int nwa = (WT_ITEMS - WT_IN + 1) / 2 - wpre, nwb = (layer == 0 && G != 256) ? (WT_IN + 1) / 2 : 0;
      const int total = 128 + nattn + nwa + nwb;
      volatile int* slot = (volatile int*)(smem + SMEM_BYTES + 8);
#ifdef PROBE_MIX
      for (int rep = 0; rep < 2; ++rep)
#endif
      for (;;) {
        __syncthreads();
#ifdef PROBE_MIX
        if (tidx() == 0) *slot = (int)xb_add(&p.bar[XB_QUEUE(layer + 2 * rep)], 1u) + (rep == 1 && PROBE_MIX == 2 ? 128 : 0);
        __syncthreads();
        const int it = *slot;
        if (it >= ((rep == 1 && PROBE_MIX == 1) ? 128 : total)) break;
#else
        if (tidx() == 0) *slot = (int)xb_add(&p.bar[XB_QUEUE(layer)], 1u);
        __syncthreads();
        const int it = *slot;
        if (it >= total) break;
#endif
        if (it < 128) {
          const int mx = it & 1, dir = (it >> 1) & 1, h = (it >> 2) & 3, b = (it >> 4) & 7;
          if (mx == 0) scan_item<0>(p, layer, dir, b, h, (float*)smem); else scan_item_gdn(p, layer, dir, b, h, (float*)smem);
        } else if (it < 128 + nattn) attn_item(p, layer, it - 128, smem);
        else if (it < 128 + nattn + nwa) weight_pair(p, layer, WT_IN, WT_ITEMS, wpre + it - 128 - nattn, smem);
        else weight_pair(p, layer + 1, 0, WT_IN, it - 128 - nattn - nwa, smem);
      }
    } break;
    case 2: finish_phase(p, layer); break;
    case 3: do_mix = true; gA = p.Abuf; gB = p.WoutT; gK = D; gnM = NLAT / 256; break;
    case 4:
      if (layer == 0 && G > 64) {
        if (bid < 32) { do_mix = true; gA = p.Abuf; gB = p.WoutT; gK = D; gnM = NCTX / 256; gpm = NLAT / 256; gG = 32; gc = bid; }
        else { do_upd = true; uwhich = 1; umode = 1; ubofs = 32; unb = G - 32; }
      } else if (layer == 0) { do_mix = true; gA = p.Abuf; gB = p.WoutT; gK = D; gnM = NCTX / 256; gpm = NLAT / 256; }
      else { do_upd = true; uwhich = 1; }
      break;
    case 5: do_upd = true; uwhich = 1; umode = (G > 64) ? 2 : 0; break;
    case 6:
      gemm_phase<EPI_CONV, 1>(p, layer, lds, p.Abuf, p.WupT, D, (layer == 1) ? HB_NLAT / 4 : (HB_NLAT + HB_NCTX) / 4, 22);
      if (layer == 0 && G == 256 && bid >= 180) for (int k = 0; k < 7; ++k) weight_pair(p, 1, 0, WT_IN, (bid - 180) + k * 76, smem);
      break;
    case 7: do_mix = true; gA = p.act; gB = p.WdownT; gK = DFF; gnM = NLAT / 256; break;
    case 8:
      if (layer == 0 && G > 64) {
        if (bid < 32) { do_mix = true; gA = p.act; gB = p.WdownT; gK = DFF; gnM = NCTX / 256; gpm = NLAT / 256; gG = 32; gc = bid; }
        else { do_upd = true; uwhich = 2; umode = 1; ubofs = 32; unb = G - 32; }
      } else if (layer == 0) { do_mix = true; gA = p.act; gB = p.WdownT; gK = DFF; gnM = NCTX / 256; gpm = NLAT / 256; }
      else { do_upd = true; uwhich = 2; }
      break;
    case 9: do_upd = true; uwhich = 2; umode = (G > 64) ? 2 : 0; break;
  }
  if (do_mix) gemm_phase<EPI_MIX, 0>(p, layer, lds, gA, gB, gK, gnM, 4, gpm, gG, gc);
  if (do_upd) update_phase(p, layer, uwhich, umode, ubofs, unb);
}

__global__ void __launch_bounds__(NTHR, 2) mega_kernel(Params p) {
  extern __shared__ __attribute__((aligned(16))) unsigned char lds_dyn[];
  char* smem = (char*)lds_dyn;
  volatile LAS unsigned* st = (volatile LAS unsigned*)((LAS unsigned char*)lds_dyn + SMEM_BYTES);
  if (threadIdx.x == 0) { st[0] = 0u; st[1] = 0u; st[2] = 0u; st[3] = 0u; }
  __syncthreads();
  XcdBarrier xb = xcd_barrier_post(p.bar, st);
  if (p.phase_end > 1000) cg::this_grid().sync();
  for (int ph = p.phase_begin; ph < p.phase_end; ++ph) {
    if (ph > p.phase_begin) xcd_barrier(xb);
    run_phase(p, ph, smem);
#ifdef PROBE_MASK
    if (ph >= 2 && ((PROBE_MASK >> ((ph - 2) & 7)) & 1)) { __syncthreads(); run_phase(p, ph, smem); }
    if (ph < 2 && (PROBE_MASK & 0x100)) { __syncthreads(); run_phase(p, ph, smem); }
#endif
  }
}

extern "C" void kernel_launch(void* const* d_in, const int* in_sizes, int n_in, void* d_out, int out_size, void* d_ws, size_t ws_size,
                              hipStream_t stream) {
  Params p{};
  p.x = (const float*)d_in[0]; p.c = (const float*)d_in[1]; p.ctx = (const float*)d_in[2]; p.c_ctx = (const float*)d_in[3];
  p.ada_w = (const float*)d_in[4]; p.ada_b = (const float*)d_in[5]; p.norm_g = (const float*)d_in[6]; p.w_in = (const float*)d_in[7];
  p.w_out = (const float*)d_in[8]; p.da_lambda = (const float*)d_in[9]; p.da_subln_g = (const float*)d_in[10];
  p.hg_lb_logits = (const float*)d_in[11]; p.hg_norm_g = (const float*)d_in[12]; p.gd_conv_w = (const float*)d_in[13];
  p.gd_a_log = (const float*)d_in[14]; p.gd_dt_bias = (const float*)d_in[15]; p.gd_norm_g = (const float*)d_in[16];
  p.ffn_w_up = (const float*)d_in[17]; p.ffn_conv_w = (const float*)d_in[18]; p.ffn_conv_b = (const float*)d_in[19];
  p.ffn_w_down = (const float*)d_in[20];
  p.out = (float*)d_out;
  char* w = (char*)d_ws;
  size_t off = 0;
  auto take = [&](size_t bytes) { char* r = w + off; off += (bytes + 255) & ~(size_t)255; return r; };
  p.WinT = (bf16_t*)take((size_t)INW * D * 2);
  p.WvT = (bf16_t*)take((size_t)512 * D * 2);
  p.WoutT = (bf16_t*)take((size_t)D * D * 2);
  p.WupT = (bf16_t*)take((size_t)2 * DFF * D * 2);
  p.WdownT = (bf16_t*)take((size_t)D * DFF * 2);
  p.mod = (float*)take((size_t)2 * 9 * 6144 * 4);
  p.ropec = (float*)take((size_t)SEQ * 32 * 4);
  p.ropes = (float*)take((size_t)SEQ * 32 * 4);
  p.cx = (float*)take((size_t)NCTX * D * 4);
  p.bar = (unsigned*)take((size_t)BAR_WORDS_TOTAL * 4);
  p.Abuf = (bf16_t*)take((size_t)(NROW + 8) * D * 2);
  char* region = w + off;
  p.P = (bf16_t*)region;
  p.Vt = (bf16_t*)(region + (size_t)NROW * PW * 2);
  p.raw = (bf16_t*)(region + (size_t)NROW * PW * 2 + (size_t)NB * 4 * 128 * NKEY * 2);
  p.mix = (bf16_t*)region;
  p.act = (bf16_t*)(region + (size_t)NROW * D * 4);

  static int grid_blocks = 0;
  if (!grid_blocks) {
    int dev = 0, cus = 0, per_cu = 0;
    (void)hipGetDevice(&dev);
    (void)hipDeviceGetAttribute(&cus, hipDeviceAttributeMultiprocessorCount, dev);
    if (hipFuncSetAttribute((const void*)mega_kernel, hipFuncAttributeMaxDynamicSharedMemorySize, LDS_TOTAL) != hipSuccess)
      fprintf(stderr, "hipFuncSetAttribute(MaxDynamicSharedMemorySize=%d) failed\n", LDS_TOTAL);
    (void)hipOccupancyMaxActiveBlocksPerMultiprocessor(&per_cu, (const void*)mega_kernel, NTHR, LDS_TOTAL);
    (void)hipGetLastError();
    grid_blocks = cus;
  }
  (void)hipMemsetAsync(p.bar, 0, (size_t)BAR_WORDS_TOTAL * 4, stream);
#ifdef MK_MULTI
  for (int ph = 0; ph < NPHASE; ++ph) {
    p.phase_begin = ph; p.phase_end = ph + 1;
    hipLaunchKernelGGL(mega_kernel, dim3(grid_blocks), dim3(NTHR), LDS_TOTAL, stream, p);
  }
#else
  p.phase_begin = 0; p.phase_end = NPHASE;
  void* args[] = {&p};
  hipError_t e = hipLaunchCooperativeKernel((void*)mega_kernel, dim3(grid_blocks), dim3(NTHR), args, LDS_TOTAL, stream);
  if (e != hipSuccess) fprintf(stderr, "cooperative launch failed: %s (grid %d)\n", hipGetErrorString(e), grid_blocks);
#endif
}
```

```cpp
#include <hip/hip_runtime.h>
#include <hip/hip_cooperative_groups.h>
#include <cstdio>
namespace cg = cooperative_groups;

typedef unsigned short bf16_t;
using bf16x8 = __attribute__((ext_vector_type(8))) short;
using f32x4 = __attribute__((ext_vector_type(4))) float;
using u32x4 = __attribute__((ext_vector_type(4))) unsigned;
using u32x2 = __attribute__((ext_vector_type(2))) unsigned;
#define DI __device__ __forceinline__
DI int tidx() { int t = threadIdx.x; asm volatile("" : "+v"(t)); return t; }
DI int bidx() { int t = blockIdx.x; asm volatile("" : "+s"(t)); return t; }
DI u32x4 mk4(unsigned a, unsigned b, unsigned c, unsigned d) { u32x4 r = {a, b, c, d}; return r; }
DI u32x2 mk2(unsigned a, unsigned b) { u32x2 r = {a, b}; return r; }

constexpr int D = 1024, NB = 8, SEQ = 2048, CTXL = 256;
constexpr int NLAT = NB * SEQ, NCTX = NB * CTXL, NROW = NLAT + NCTX;
constexpr int INC = 3856, PW = 3344, DFF = 2816, NKEY = 2304;
constexpr int PC_Q = 0, PC_K = 512, PC_HQ = 1024, PC_HI = 1280, PC_HF = 1536, PC_HG = 2048, PC_GQKV = 2304, PC_GA = 3072, PC_GB = 3080, PC_GG = 3088;
constexpr int SMEM_BYTES = 131072;
constexpr int LDS_TOTAL = SMEM_BYTES + 64;
constexpr int NTHR = 512, NWAVE = 8;
constexpr int INW = 3584;
constexpr int NPHASE = 20;

struct Params {
  const float *x, *c, *ctx, *c_ctx, *ada_w, *ada_b, *norm_g, *w_in, *w_out, *da_lambda, *da_subln_g,
      *hg_lb_logits, *hg_norm_g, *gd_conv_w, *gd_a_log, *gd_dt_bias, *gd_norm_g, *ffn_w_up, *ffn_conv_w, *ffn_conv_b, *ffn_w_down;
  float* out;
  bf16_t *WinT, *WvT, *WoutT, *WupT, *WdownT;
  float *mod, *ropec, *ropes, *cx;
  bf16_t *Abuf, *P, *Vt, *raw;
  bf16_t* mix;
  bf16_t* act;
  unsigned* bar;
  int phase_begin, phase_end;
};

typedef __bf16 hbf2 __attribute__((ext_vector_type(2)));
typedef float f32x2 __attribute__((ext_vector_type(2)));
DI unsigned pack2(float a, float b) { f32x2 v = {a, b}; hbf2 r = __builtin_convertvector(v, hbf2); return __builtin_bit_cast(unsigned, r); }
DI bf16_t f2bf(float x) { return (bf16_t)(pack2(x, x) & 0xffffu); }
DI float bf2f(bf16_t h) { return __uint_as_float(((unsigned)h) << 16); }
DI float silu_f(float x) { return x / (1.f + __expf(-x)); }
DI float sigmoid_f(float x) { return 1.f / (1.f + __expf(-x)); }
DI float quad_sum(float v) {
  int i = __float_as_int(v);
  v += __int_as_float(__builtin_amdgcn_update_dpp(0, i, 0xB1, 0xF, 0xF, true));
  i = __float_as_int(v);
  v += __int_as_float(__builtin_amdgcn_update_dpp(0, i, 0x4E, 0xF, 0xF, true));
  return v;
}
DI void unpack8(u32x4 u, float* f) {
  f[0] = __uint_as_float(u.x << 16); f[1] = __uint_as_float(u.x & 0xffff0000u);
  f[2] = __uint_as_float(u.y << 16); f[3] = __uint_as_float(u.y & 0xffff0000u);
  f[4] = __uint_as_float(u.z << 16); f[5] = __uint_as_float(u.z & 0xffff0000u);
  f[6] = __uint_as_float(u.w << 16); f[7] = __uint_as_float(u.w & 0xffff0000u);
}


#define XB_TMO      128
#define XB_XCNT(j)  (256  + 64 * (j))
#define XB_XSUB(j)  (1280 + 64 * (j))
#define XB_XGEN(j)  (2304 + 64 * (j))
#define XB_TOP      3328
#define XB_TOPGEN   3392
#define XCD_BAR_WORDS 3456
#define XB_QUEUE(l) (3456 + 64 * (l))
#define BAR_WORDS_TOTAL 3712
#define XB_SPIN_CAP (1u << 23)
#define LAS __attribute__((address_space(3)))
DI unsigned xb_ld(unsigned* p) { return __hip_atomic_load(p, __ATOMIC_RELAXED, __HIP_MEMORY_SCOPE_AGENT); }
DI unsigned xb_add(unsigned* p, unsigned v) { return __hip_atomic_fetch_add(p, v, __ATOMIC_RELAXED, __HIP_MEMORY_SCOPE_AGENT); }
DI unsigned xb_xcc_id() { return (unsigned)__builtin_amdgcn_s_getreg((3 << 11) | 20) & 0xFu; }
#define XB_SPIN(cond, bar) do { unsigned _sp = 0; while (cond) { __builtin_amdgcn_s_sleep(1); \
    if ((++_sp & 255u) == 0u) { if (xb_ld(&(bar)[XB_TMO])) break; if (_sp > XB_SPIN_CAP) { atomicAdd(&(bar)[XB_TMO], 1u); break; } } } } while (0)
struct XcdBarrier { unsigned* bar; unsigned x; volatile LAS unsigned* st; };
DI XcdBarrier xcd_barrier_post(unsigned* bar, volatile LAS unsigned* st) {
  XcdBarrier b; b.bar = bar; b.x = xb_xcc_id(); b.st = st;
  if (threadIdx.x == 0) (void)xb_add(&bar[XB_XCNT(b.x)], 1u);
  return b;
}
DI void xcd_barrier_complete(unsigned* bar, unsigned x, unsigned& nloc, unsigned& nx) {
  const unsigned G = gridDim.x * gridDim.y * gridDim.z;
  unsigned sum, cnt, mine, sp = 0u;
  for (;;) {
    sum = 0u; cnt = 0u; mine = 0u;
#pragma unroll
    for (unsigned j = 0; j < 16; ++j) { const unsigned c = xb_ld(&bar[XB_XCNT(j)]); sum += c; cnt += (c > 0u) ? 1u : 0u; mine = (j == x) ? c : mine; }
    if (sum == G) break;
    __builtin_amdgcn_s_sleep(1);
    if ((++sp & 255u) == 0u) { if (xb_ld(&bar[XB_TMO])) break; if (sp > XB_SPIN_CAP) { atomicAdd(&bar[XB_TMO], 1u); break; } }
  }
  nloc = mine > 0u ? mine : 1u; nx = cnt > 0u ? cnt : 1u;
}
DI void xcd_barrier(const XcdBarrier& b) {
  asm volatile("s_waitcnt vmcnt(0)" ::: "memory");
  __syncthreads();
  if (threadIdx.x == 0) {
    unsigned* bar = b.bar;
    __builtin_amdgcn_s_waitcnt(0);
    unsigned nloc = b.st[0], nx = b.st[1];
    if (nloc == 0u) { xcd_barrier_complete(bar, b.x, nloc, nx); b.st[0] = nloc; b.st[1] = nx; }
    const unsigned old = xb_add(&bar[XB_XSUB(b.x)], 1u);
    const unsigned gen = old / nloc;
    if (old + 1u == (gen + 1u) * nloc) {
      __builtin_amdgcn_fence(__ATOMIC_RELEASE, "agent");
      asm volatile("s_waitcnt vmcnt(0)" ::: "memory");
      const unsigned og = xb_add(&bar[XB_TOP], 1u);
      const unsigned tg = og / nx;
      if (og + 1u == (tg + 1u) * nx) xb_add(&bar[XB_TOPGEN], 1u);
      else XB_SPIN(xb_ld(&bar[XB_TOPGEN]) == tg, bar);
      __builtin_amdgcn_fence(__ATOMIC_ACQUIRE, "agent");
      xb_add(&bar[XB_XGEN(b.x)], 1u);
      asm volatile("s_waitcnt vmcnt(0)" ::: "memory");
    } else {
      XB_SPIN(xb_ld(&bar[XB_XGEN(b.x)]) == gen, bar);
      __builtin_amdgcn_fence(__ATOMIC_ACQUIRE, "agent");
      asm volatile("s_waitcnt vmcnt(0)" ::: "memory");
    }
  }
  __syncthreads();
}

DI void transpose_tile(const float* __restrict__ W, int K, int N, bf16_t* __restrict__ WT, bf16_t* __restrict__ WT2, int kt, int nt, int mode, float* lds, bool valid) {
  const int tid = tidx() & 255;
  const int k0 = kt * 64, n0 = nt * 64;
  if (valid) {
#pragma unroll
    for (int pp = 0; pp < 4; ++pp) {
      int r = pp * 16 + (tid >> 4), c = (tid & 15) * 4;
      float4 v = make_float4(0.f, 0.f, 0.f, 0.f);
      int n = n0 + c;
      if (n + 3 < N) { const f32x4 t4 = __builtin_nontemporal_load((const f32x4*)(W + (size_t)(k0 + r) * N + n)); v = make_float4(t4[0], t4[1], t4[2], t4[3]); }
      lds[r * 65 + c + 0] = v.x; lds[r * 65 + c + 1] = v.y; lds[r * 65 + c + 2] = v.z; lds[r * 65 + c + 3] = v.w;
    }
  }
  __syncthreads();
  if (valid) {
    int nl = tid >> 2, kq = tid & 3;
    int n = n0 + nl;
    bf16_t* dstbase = WT;
    int orow = n;
    if (mode == 1) orow = (n < DFF) ? ((n >> 7) * 256 + (n & 127)) : (((n - DFF) >> 7) * 256 + 128 + ((n - DFF) & 127));
    if (mode == 2) {
      if (n < 1024) { const int d = n & 63; orow = (n & ~63) + (d < 32 ? 2 * d : 2 * (d - 32) + 1); }
      else if (n < 1536) { orow = n - 1024; dstbase = WT2; }
      else orow = n - 512;
    }
    if (n < N) {
      unsigned w[8];
#pragma unroll
      for (int i = 0; i < 8; ++i) w[i] = pack2(lds[(kq * 16 + 2 * i) * 65 + nl], lds[(kq * 16 + 2 * i + 1) * 65 + nl]);
      u32x4* dst = (u32x4*)(dstbase + (size_t)orow * K + k0 + kq * 16);
      dst[0] = mk4(w[0], w[1], w[2], w[3]);
      dst[1] = mk4(w[4], w[5], w[6], w[7]);
    }
  }
  __syncthreads();
}

constexpr int WT_IN = 16 * 61, WT_OUT = 16 * 16, WT_UP = 16 * 88, WT_DOWN = 44 * 16;
constexpr int WT_ITEMS = WT_IN + WT_OUT + WT_UP + WT_DOWN;
constexpr int WPRE = 112 * 7;
DI void weight_item(const Params& p, int layer, int it, float* lds, bool valid) {
  if (it < WT_IN) { transpose_tile(p.w_in + (size_t)layer * D * INC, D, INC, p.WinT, p.WvT, it % 16, it / 16, 2, lds, valid); return; }
  it -= WT_IN;
  if (it < WT_OUT) { transpose_tile(p.w_out + (size_t)layer * D * D, D, D, p.WoutT, nullptr, it % 16, it / 16, 0, lds, valid); return; }
  it -= WT_OUT;
  if (it < WT_UP) { transpose_tile(p.ffn_w_up + (size_t)layer * D * 2 * DFF, D, 2 * DFF, p.WupT, nullptr, it % 16, it / 16, 1, lds, valid); return; }
  it -= WT_UP;
  transpose_tile(p.ffn_w_down + (size_t)layer * DFF * D, DFF, D, p.WdownT, nullptr, it % 44, it / 44, 0, lds, valid);
}
DI void weight_pair(const Params& p, int layer, int first, int last, int pair, char* smem) {
  const int half = tidx() >> 8;
  float* lds = (float*)smem + half * 4224;
  const int it = first + pair * 2 + half;
  const bool valid = it < last;
  weight_item(p, layer, valid ? it : last - 1, lds, valid);
}

DI void mod_item(const Params& p, int it2, float* lds) {
  const int tid = tidx() & 255, half = tidx() >> 8;
  const int it = it2 * 2 + half;
  const int layer = it / 192, n0 = (it % 192) * 32;
  float* sc = lds;
  float* red = lds + 9 * 1024 + half * 9216;
  for (int i = tidx(); i < 9 * 1024; i += NTHR) {
    float v = (i < 8 * 1024) ? p.c[i] : p.c_ctx[i - 8 * 1024];
    sc[i] = silu_f(v);
  }
  __syncthreads();
  const int kg = tid >> 3, c4 = (tid & 7) * 4;
  f32x4 acc[9];
#pragma unroll
  for (int i = 0; i < 9; ++i) acc[i] = (f32x4){0.f, 0.f, 0.f, 0.f};
  const float* w = p.ada_w + (size_t)layer * D * 6144 + n0 + c4;
#pragma unroll 4
  for (int kb = 0; kb < 32; kb += 8) {
    f32x4 wv[8];
#pragma unroll
    for (int u = 0; u < 8; ++u) wv[u] = __builtin_nontemporal_load((const f32x4*)(w + (size_t)(kg * 32 + kb + u) * 6144));
#pragma unroll
    for (int u = 0; u < 8; ++u)
#pragma unroll
      for (int i = 0; i < 9; ++i) acc[i] += wv[u] * sc[i * 1024 + kg * 32 + kb + u];
  }
#pragma unroll
  for (int i = 0; i < 9; ++i) *(f32x4*)(red + (kg * 9 + i) * 32 + c4) = acc[i];
  __syncthreads();
  for (int t = tid; t < 288; t += 256) {
    int i = t >> 5, cc = t & 31;
    float sacc = p.ada_b[layer * 6144 + n0 + cc];
#pragma unroll 8
    for (int g = 0; g < 32; ++g) sacc += red[(g * 9 + i) * 32 + cc];
    p.mod[(size_t)(layer * 9 + i) * 6144 + n0 + cc] = sacc;
  }
  __syncthreads();
}

DI void rope_item(const Params& p, int it) {
  for (int i = 0; i < 2; ++i) {
    int idx = it * 1024 + i * 512 + tidx();
    int t = idx >> 5, j = idx & 31;
    float pos = (float)((j < 16) ? (t >> 6) : (t & 63));
    float inv = exp2f(-(float)(j & 15) * (13.287712379549449f / 16.f));
    float ang = pos * inv;
    double rev = (double)ang * 0.15915494309189535;
    rev -= floor(rev);
    float fr = (float)rev;
    p.ropec[idx] = __builtin_amdgcn_cosf(fr);
    p.ropes[idx] = __builtin_amdgcn_sinf(fr);
  }
}

DI float wave_sum(float v) {
#pragma unroll
  for (int o = 32; o >= 1; o >>= 1) v += __shfl_xor(v, o);
  return v;
}
DI void update_phase(const Params& p, int layer, int which, int mode, int bofs, int nb) {
  const int lane = tidx() & 63, wid = tidx() >> 6;
  const int nrows = (layer == 1) ? NLAT : NROW;
  const bool last = (layer == 1 && which == 2);
  const int gw = (bidx() - bofs) * NWAVE + wid, nw = nb * NWAVE;
  const int nl = (which == 2) ? layer + 1 : layer;
  const int gi = (which == 1) ? 2 : 0, sh = (which == 1) ? 3 : 0;
  const bool from_in = (layer == 0 && which <= 1);
  float4 pg[4], pgt[4], ng[4], nsf[4], nsc[4];
  auto load_params = [&](int mi) {
    const float* modp = p.mod + (size_t)(layer * 9 + mi) * 6144;
    const float* gate = modp + (which == 1 ? 2 : 5) * 1024;
    const float* gp = p.norm_g + (size_t)(layer * 4 + (which == 1 ? 1 : 3)) * 1024;
    const float* modn = p.mod + (size_t)(nl * 9 + mi) * 6144;
    const float* gn = p.norm_g + (size_t)(nl * 4 + gi) * 1024;
#pragma unroll
    for (int i = 0; i < 4; ++i) {
      if (which != 0) { pg[i] = *(const float4*)(gp + i * 256 + lane * 4); pgt[i] = *(const float4*)(gate + i * 256 + lane * 4); }
      if (!last) {
        ng[i] = *(const float4*)(gn + i * 256 + lane * 4);
        nsf[i] = *(const float4*)(modn + sh * 1024 + i * 256 + lane * 4);
        nsc[i] = *(const float4*)(modn + (sh + 1) * 1024 + i * 256 + lane * 4);
      }
    }
  };
  auto row_src = [&](int r) -> const float* {
    if (r < NLAT) return from_in ? p.x + (size_t)r * D : p.out + (size_t)r * D;
    return from_in ? p.ctx + (size_t)(r - NLAT) * D : p.cx + (size_t)(r - NLAT) * D;
  };
  auto load_row = [&](int r, float4 (&xv)[4], u32x2 (&um)[4]) {
    const float* xs = row_src(r);
#pragma unroll
    for (int i = 0; i < 4; ++i) { const f32x4 t4 = __builtin_nontemporal_load((const f32x4*)(xs + i * 256 + lane * 4)); xv[i] = make_float4(t4[0], t4[1], t4[2], t4[3]); }
    if (which != 0) {
      const bf16_t* mr = p.mix + (size_t)r * D;
#pragma unroll
      for (int i = 0; i < 4; ++i) um[i] = __builtin_nontemporal_load((const u32x2*)(mr + i * 256 + lane * 4));
    }
  };
  auto do_row = [&](int r, float4 (&xv)[4], const u32x2 (&um)[4]) {
    float* xd = (r < NLAT) ? p.out + (size_t)r * D : p.cx + (size_t)(r - NLAT) * D;
    if (which != 0) {
      float4 mv[4];
      float ss = 0.f;
#pragma unroll
      for (int i = 0; i < 4; ++i) {
        mv[i] = make_float4(__uint_as_float(um[i].x << 16), __uint_as_float(um[i].x & 0xffff0000u), __uint_as_float(um[i].y << 16), __uint_as_float(um[i].y & 0xffff0000u));
        ss += mv[i].x * mv[i].x + mv[i].y * mv[i].y + mv[i].z * mv[i].z + mv[i].w * mv[i].w;
      }
      ss = wave_sum(ss);
      const float rstd = rsqrtf(ss * (1.f / 1024.f) + 1e-6f);
#pragma unroll
      for (int i = 0; i < 4; ++i) {
        xv[i].x += pgt[i].x * (mv[i].x * rstd * pg[i].x);
        xv[i].y += pgt[i].y * (mv[i].y * rstd * pg[i].y);
        xv[i].z += pgt[i].z * (mv[i].z * rstd * pg[i].z);
        xv[i].w += pgt[i].w * (mv[i].w * rstd * pg[i].w);
        { const f32x4 t4 = {xv[i].x, xv[i].y, xv[i].z, xv[i].w}; __builtin_nontemporal_store(t4, (f32x4*)(xd + i * 256 + lane * 4)); }
      }
    }
    if (!last) {
      float ss = 0.f;
#pragma unroll
      for (int i = 0; i < 4; ++i) ss += xv[i].x * xv[i].x + xv[i].y * xv[i].y + xv[i].z * xv[i].z + xv[i].w * xv[i].w;
      ss = wave_sum(ss);
      const float rstd = rsqrtf(ss * (1.f / 1024.f) + 1e-6f);
      bf16_t* dst = p.Abuf + (size_t)r * D;
#pragma unroll
      for (int i = 0; i < 4; ++i) {
        float a = (xv[i].x * rstd * ng[i].x) * (1.f + nsc[i].x) + nsf[i].x;
        float b = (xv[i].y * rstd * ng[i].y) * (1.f + nsc[i].y) + nsf[i].y;
        float c = (xv[i].z * rstd * ng[i].z) * (1.f + nsc[i].z) + nsf[i].z;
        float d = (xv[i].w * rstd * ng[i].w) * (1.f + nsc[i].w) + nsf[i].w;
        *(u32x2*)(dst + i * 256 + lane * 4) = mk2(pack2(a, b), pack2(c, d));
      }
    }
  };
  if (mode == 2) {
    float4 xa[4];
    u32x2 ma[4];
    load_params(8);
    for (int rc = NLAT + gw; rc < NROW; rc += nw) { load_row(rc, xa, ma); do_row(rc, xa, ma); }
  } else if ((nw & 7) == 0 && nw <= 8 * SEQ) {
    const int wpb = nw >> 3, bb = gw / wpb, wl = gw % wpb;
    load_params(bb);
    float4 xa[4], xb[4];
    u32x2 ma[4], mb[4];
    int r = bb * SEQ + wl;
    const int rend = (bb + 1) * SEQ;
    if (r < rend) load_row(r, xa, ma);
    while (r < rend) {
      const int r2 = r + wpb;
      if (r2 < rend) load_row(r2, xb, mb);
      do_row(r, xa, ma);
      if (r2 >= rend) break;
      const int r3 = r2 + wpb;
      if (r3 < rend) load_row(r3, xa, ma);
      do_row(r2, xb, mb);
      r = r3;
    }
    if (mode == 0 && nrows > NLAT) {
      load_params(8);
      for (int rc = NLAT + gw; rc < NROW; rc += nw) { load_row(rc, xa, ma); do_row(rc, xa, ma); }
    }
  } else {
    float4 xa[4];
    u32x2 ma[4];
    for (int r = gw; r < (mode == 1 ? NLAT : nrows); r += nw) { load_params((r < NLAT) ? (r >> 11) : 8); load_row(r, xa, ma); do_row(r, xa, ma); }
  }
}

constexpr int EPI_P = 0, EPI_MIX = 1, EPI_CONV = 2, EPI_VT = 3;
constexpr int G_BM = 256, G_BK = 64, G_HALF = 128, G_HTB = G_HALF * G_BK * 2, G_STAGE_BYTES = 8 * G_HTB, G_NXCD = 8, G_WGM = 8;
constexpr int HB_LAT = 34, HB_CTX = 5, HB_NLAT = NB * HB_LAT, HB_NCTX = NB * HB_CTX;
DI int g_lds_byte(int r, int c) { const int st = (r >> 4) * 2 + (c >> 5), rr = r & 15, cc = c & 31, ob = rr * 64 + cc * 2; return st * 1024 + (ob ^ (((ob >> 9) & 1) << 5)); }
DI void g_stage_rc(int b, int& R, int& C) { const int st = b / 1024, sb = b % 1024, swz = sb ^ (((sb >> 9) & 1) << 5); R = (st >> 1) * 16 + swz / 64; C = (st & 1) * 32 + (swz % 64) / 2; }
DI int g_perm32(int rho) { const int n = rho >> 4, i = rho & 15; return 8 * (i >> 2) + 4 * n + (i & 3); }
struct GUnit { int pm, pn; };
struct GOrder {
  int nM, nN, nwg, G, c;
  DI void init(int nM_, int nN_, int G_, int c_) { nM = nM_; nN = nN_; nwg = nM * nN; G = G_; c = c_; }
  DI bool next(int i, GUnit& u) const {
    const long L = (long)i * G + c; if (L >= nwg) return false;
    int wgid = (int)L; { const int q = nwg / G_NXCD, r = nwg % G_NXCD, xcd = wgid % G_NXCD, off = wgid / G_NXCD; wgid = (xcd < r ? xcd * (q + 1) : r * (q + 1) + (xcd - r) * q) + off; }
    const int nig = G_WGM * nN, gid = wgid / nig, fm = gid * G_WGM, gsz = (nM - fm) < G_WGM ? (nM - fm) : G_WGM;
    u.pm = fm + ((wgid % nig) % gsz); u.pn = (wgid % nig) / gsz; return true;
  }
};
DI void halo_block(int blk, int& base, int& L, int& t0) {
  if (blk < HB_NLAT) { const int s = blk / HB_LAT, i = blk % HB_LAT; base = s * SEQ; L = SEQ; t0 = 62 * i - 1; }
  else { const int b2 = blk - HB_NLAT; const int s = b2 / HB_CTX, i = b2 % HB_CTX; base = NLAT + s * CTXL; L = CTXL; t0 = 62 * i - 1; }
}
template <int AMODE>
DI void g_a_offsets(int pm, int K, const int (&R)[2], const int (&C)[2], unsigned (&o)[2][2]) {
#pragma unroll
  for (int h = 0; h < 2; ++h)
#pragma unroll
    for (int i = 0; i < 2; ++i) {
      const int tr = h * 128 + R[i];
      int grow;
      if (AMODE == 0) grow = pm * 256 + tr;
      else {
        int base, L, t0; halo_block(pm * 4 + (tr >> 6), base, L, t0);
        const int t = t0 + (tr & 63);
        grow = (t >= 0 && t < L) ? base + t : NROW;
      }
      o[h][i] = (unsigned)(grow * K + C[i]) * 2u;
    }
}

template <int EPI> DI void g_epilogue(const Params& p, int layer, const f32x4 (&acc)[2][2][4][2], const GUnit& u, int wr, int wc, int fr, int fq);

template <int EPI, int AMODE>
DI void gemm_phase(const Params& p, int layer, LAS unsigned char* lds, const bf16_t* A, const bf16_t* Bt, int K, int nM, int nN, int pm_base = 0, int Gov = 0, int cov = 0) {
  const int tid = tidx(), wid = __builtin_amdgcn_readfirstlane(tid >> 6), lane = tid & 63, wr = wid >> 2, wc = wid & 3, fr = lane & 15, fq = lane >> 4;
  const int nt = K / G_BK;
  int sR[2], sC[2];
  unsigned voffB[2];
#pragma unroll
  for (int i = 0; i < 2; ++i) { g_stage_rc(tid * 16 + i * 8192, sR[i], sC[i]); const int Rb = (sR[i] & ~31) + g_perm32(sR[i] & 31); voffB[i] = (unsigned)(Rb * K + sC[i]) * 2u; }
  const size_t kstep = (size_t)(G_BK * 2);
  const size_t hstep = (size_t)G_HALF * K * 2;
  const size_t tstep = 2 * hstep;
  const unsigned ldsw = (unsigned)wid * 1024u;
  const int aoff = g_lds_byte(wr * 64 + fr, fq * 8), boff = g_lds_byte(wc * 32 + fr, fq * 8);
  const char* gA = (const char*)A;
#define PG8_SA(b, h) (((b) * 2 + (h)) * G_HTB)
#define PG8_SB(b, h) ((4 + (b) * 2 + (h)) * G_HTB)
#define PG8_STAGE(bufoff, gbase, voff) do { _Pragma("unroll") for (int _i = 0; _i < 2; ++_i) \
    __builtin_amdgcn_global_load_lds((const unsigned*)((const char*)(gbase) + (voff)[_i]), (LAS unsigned*)(lds + (bufoff) + ldsw + _i * 8192), 16, 0, 0); } while (0)
#define PG8_LDA(dst, b, h) do { _Pragma("unroll") for (int m = 0; m < 4; ++m) _Pragma("unroll") for (int k = 0; k < 2; ++k) dst[m][k] = *(const LAS bf16x8*)(lds + PG8_SA(b, h) + aoff + m * 2048 + k * 1024); } while (0)
#define PG8_LDB(dst, b, h) do { _Pragma("unroll") for (int n = 0; n < 2; ++n) _Pragma("unroll") for (int k = 0; k < 2; ++k) dst[n][k] = *(const LAS bf16x8*)(lds + PG8_SB(b, h) + boff + n * 2048 + k * 1024); } while (0)
#define PG8_MMA(ai, bj, At, Bt_) do { __builtin_amdgcn_s_setprio(1); _Pragma("unroll") for (int m = 0; m < 4; ++m) _Pragma("unroll") for (int n = 0; n < 2; ++n) _Pragma("unroll") for (int k = 0; k < 2; ++k) \
    acc[ai][bj][m][n] = __builtin_amdgcn_mfma_f32_16x16x32_bf16(Bt_[n][k], At[m][k], acc[ai][bj][m][n], 0, 0, 0); __builtin_amdgcn_s_setprio(0); } while (0)
#define PG8_WAIT_V(n) asm volatile("s_waitcnt vmcnt(" #n ")" ::: "memory")
#define PG8_WAIT_L(n) asm volatile("s_waitcnt lgkmcnt(" #n ")" ::: "memory")
#define PG8_BAR __builtin_amdgcn_s_barrier()
#define PG8_SCHED __builtin_amdgcn_sched_barrier(0)
  GOrder S; S.init(nM, nN, Gov ? Gov : (int)gridDim.x, Gov ? cov : bidx());
  GUnit cur, nxt; int ui = 0;
  if (!S.next(0, cur)) return;
  cur.pm += pm_base;
  f32x4 acc[2][2][4][2];
#pragma unroll
  for (int a = 0; a < 2; ++a)
#pragma unroll
    for (int b = 0; b < 2; ++b)
#pragma unroll
      for (int m = 0; m < 4; ++m)
#pragma unroll
        for (int n = 0; n < 2; ++n) acc[a][b][m][n] = (f32x4){0.f, 0.f, 0.f, 0.f};
  bf16x8 At[4][2], B0[2][2], B1[2][2];
  unsigned curA[2][2];
  g_a_offsets<AMODE>(cur.pm, K, sR, sC, curA);
  const char* cB = (const char*)Bt + (size_t)cur.pn * tstep;
  PG8_STAGE(PG8_SB(0, 0), cB, voffB); PG8_STAGE(PG8_SA(0, 0), gA, curA[0]); PG8_STAGE(PG8_SB(0, 1), cB + hstep, voffB); PG8_STAGE(PG8_SA(0, 1), gA, curA[1]);
  if (wr == 1) PG8_BAR;
  PG8_WAIT_V(4); PG8_BAR;
  PG8_STAGE(PG8_SB(1, 0), cB + kstep, voffB); PG8_STAGE(PG8_SA(1, 0), gA + kstep, curA[0]); PG8_STAGE(PG8_SB(1, 1), cB + hstep + kstep, voffB);
  PG8_WAIT_V(6); PG8_BAR;
  for (;;) {
    {
      const int tid2 = tidx();
#pragma unroll
      for (int i = 0; i < 2; ++i) { g_stage_rc(tid2 * 16 + i * 8192, sR[i], sC[i]); const int Rb = (sR[i] & ~31) + g_perm32(sR[i] & 31); voffB[i] = (unsigned)(Rb * K + sC[i]) * 2u; }
      g_a_offsets<AMODE>(cur.pm, K, sR, sC, curA);
    }
    const bool has_next = S.next(ui + 1, nxt);
    if (has_next) nxt.pm += pm_base;
    const int npm = has_next ? nxt.pm : cur.pm;
    const char* nB = has_next ? (const char*)Bt + (size_t)nxt.pn * tstep : cB;
    for (int t = 0; t < nt; t += 2) {
      const bool last = (t == nt - 2);
      const char* a1 = gA + (size_t)(t + 1) * kstep;
      const char* a2 = last ? gA : gA + (size_t)(t + 2) * kstep;
      const char* b2 = last ? nB : cB + (size_t)(t + 2) * kstep;
      const char* a3 = a2 + kstep; const char* b3 = b2 + kstep;
      unsigned a2o[2][2];
      if (last) g_a_offsets<AMODE>(npm, K, sR, sC, a2o);
      else {
#pragma unroll
        for (int h = 0; h < 2; ++h)
#pragma unroll
          for (int i = 0; i < 2; ++i) a2o[h][i] = curA[h][i];
      }
      PG8_LDB(B0, 0, 0); PG8_SCHED; PG8_LDA(At, 0, 0); PG8_STAGE(PG8_SA(1, 1), a1, curA[1]);
      PG8_WAIT_L(8); PG8_BAR; PG8_WAIT_L(0); PG8_MMA(0, 0, At, B0); PG8_BAR; PG8_SCHED;
      PG8_LDB(B1, 0, 1); PG8_STAGE(PG8_SB(0, 0), b2, voffB);
      PG8_BAR; PG8_WAIT_L(0); PG8_MMA(0, 1, At, B1); PG8_BAR;
      PG8_LDA(At, 0, 1); PG8_STAGE(PG8_SA(0, 0), a2, a2o[0]);
      PG8_BAR; PG8_WAIT_L(0); PG8_MMA(1, 0, At, B0); PG8_BAR; PG8_SCHED;
      PG8_STAGE(PG8_SB(0, 1), b2 + hstep, voffB);
      PG8_WAIT_V(6); PG8_BAR; PG8_MMA(1, 1, At, B1); PG8_BAR;
      PG8_LDB(B0, 1, 0); PG8_SCHED; PG8_LDA(At, 1, 0); PG8_STAGE(PG8_SA(0, 1), a2, a2o[1]);
      PG8_WAIT_L(8); PG8_BAR; PG8_WAIT_L(0); PG8_MMA(0, 0, At, B0); PG8_BAR; PG8_SCHED;
      PG8_LDB(B1, 1, 1); PG8_STAGE(PG8_SB(1, 0), b3, voffB);
      PG8_BAR; PG8_WAIT_L(0); PG8_MMA(0, 1, At, B1); PG8_BAR;
      PG8_LDA(At, 1, 1); PG8_STAGE(PG8_SA(1, 0), a3, a2o[0]);
      PG8_BAR; PG8_WAIT_L(0); PG8_MMA(1, 0, At, B0); PG8_BAR; PG8_SCHED;
      PG8_STAGE(PG8_SB(1, 1), b3 + hstep, voffB);
      PG8_WAIT_V(6); PG8_BAR; PG8_MMA(1, 1, At, B1); PG8_BAR;
    }
    g_epilogue<EPI>(p, layer, acc, cur, wr, wc, fr, fq);
    if (!has_next) break;
#pragma unroll
    for (int a = 0; a < 2; ++a)
#pragma unroll
      for (int b = 0; b < 2; ++b)
#pragma unroll
        for (int m = 0; m < 4; ++m)
#pragma unroll
          for (int n = 0; n < 2; ++n) acc[a][b][m][n] = (f32x4){0.f, 0.f, 0.f, 0.f};
    cur = nxt; cB = nB; ++ui;
  }
  PG8_WAIT_V(0);
  if (wr == 0) PG8_BAR;
  PG8_BAR;
#undef PG8_SA
#undef PG8_SB
#undef PG8_STAGE
#undef PG8_LDA
#undef PG8_LDB
#undef PG8_MMA
#undef PG8_WAIT_V
#undef PG8_WAIT_L
#undef PG8_BAR
#undef PG8_SCHED
}

DI float dpp_ror1(float v) { return __int_as_float(__builtin_amdgcn_update_dpp(0, __float_as_int(v), 0x121, 0xF, 0xF, true)); }
DI float dpp_ror15(float v) { return __int_as_float(__builtin_amdgcn_update_dpp(0, __float_as_int(v), 0x12F, 0xF, 0xF, true)); }
template <int EPI>
DI void g_epilogue(const Params& p, int layer, const f32x4 (&acc)[2][2][4][2], const GUnit& u, int wr, int wc, int fr, int fq) {
  if (EPI == EPI_MIX) {
#pragma unroll
    for (int ai = 0; ai < 2; ++ai)
#pragma unroll
      for (int m = 0; m < 4; ++m) {
        bf16_t* rowp = p.mix + (size_t)(u.pm * 256 + ai * 128 + wr * 64 + m * 16 + fr) * D + u.pn * 256 + wc * 32 + 8 * fq;
#pragma unroll
        for (int bj = 0; bj < 2; ++bj) {
          const f32x4 v0 = acc[ai][bj][m][0], v1 = acc[ai][bj][m][1];
          *(u32x4*)(rowp + bj * 128) = mk4(pack2(v0[0], v0[1]), pack2(v0[2], v0[3]), pack2(v1[0], v1[1]), pack2(v1[2], v1[3]));
        }
      }
  } else if (EPI == EPI_P) {
    const bool is_lat = (u.pm * 256) < NLAT;
    const bool qk = u.pn < 4;
    const float qs = (u.pn < 2) ? (0.125f * 1.4426950408889634f) : 1.f;
#pragma unroll
    for (int ai = 0; ai < 2; ++ai)
#pragma unroll
      for (int m = 0; m < 4; ++m) {
        const int row = u.pm * 256 + ai * 128 + wr * 64 + m * 16 + fr;
        bf16_t* rowp = p.P + (size_t)row * PW + u.pn * 256 + wc * 32 + 8 * fq;
        f32x4 cs = {1.f, 1.f, 1.f, 1.f}, sn = {0.f, 0.f, 0.f, 0.f};
        if (qk && is_lat) {
          const int t = row & (SEQ - 1), d0 = (wc & 1) * 16 + 4 * fq;
          cs = *(const f32x4*)(p.ropec + t * 32 + d0);
          sn = *(const f32x4*)(p.ropes + t * 32 + d0);
        }
#pragma unroll
        for (int bj = 0; bj < 2; ++bj) {
          f32x4 v0 = acc[ai][bj][m][0], v1 = acc[ai][bj][m][1];
          if (qk) {
            const f32x4 w0 = {v0[0] * cs[0] - v0[1] * sn[0], v0[1] * cs[0] + v0[0] * sn[0], v0[2] * cs[1] - v0[3] * sn[1], v0[3] * cs[1] + v0[2] * sn[1]};
            const f32x4 w1 = {v1[0] * cs[2] - v1[1] * sn[2], v1[1] * cs[2] + v1[0] * sn[2], v1[2] * cs[3] - v1[3] * sn[3], v1[3] * cs[3] + v1[2] * sn[3]};
            v0 = w0 * qs; v1 = w1 * qs;
          }
          const int col = u.pn * 256 + bj * 128 + wc * 32 + 8 * fq;
          if (col < PW) *(u32x4*)(rowp + bj * 128) = mk4(pack2(v0[0], v0[1]), pack2(v0[2], v0[3]), pack2(v1[0], v1[1]), pack2(v1[2], v1[3]));
        }
      }
  } else if (EPI == EPI_VT) {
#pragma unroll
    for (int ai = 0; ai < 2; ++ai)
#pragma unroll
      for (int m = 0; m < 4; ++m) {
        const int hh = u.pm * 2 + ai, dv = wr * 64 + m * 16 + fr;
#pragma unroll
        for (int bj = 0; bj < 2; ++bj) {
          const int tok = u.pn * 256 + bj * 128 + wc * 32 + 8 * fq;
          int bb, key;
          if (tok < NLAT) { bb = tok >> 11; key = CTXL + (tok & (SEQ - 1)); } else { bb = (tok - NLAT) >> 8; key = (tok - NLAT) & (CTXL - 1); }
          const f32x4 v0 = acc[ai][bj][m][0], v1 = acc[ai][bj][m][1];
          *(u32x4*)(p.Vt + ((size_t)((bb * 4 + hh) * 128 + dv)) * NKEY + key) = mk4(pack2(v0[0], v0[1]), pack2(v0[2], v0[3]), pack2(v1[0], v1[1]), pack2(v1[2], v1[3]));
        }
      }
  } else {
    const int f0 = u.pn * 128 + wc * 32 + 8 * fq;
    const float* cw = p.ffn_conv_w + (size_t)layer * 3 * 2 * DFF + f0;
    const float* cbp = p.ffn_conv_b + (size_t)layer * 2 * DFF + f0;
#pragma unroll
    for (int q = 0; q < 2; ++q) {
      f32x4 wg[3], wv[3], bg, bv;
#pragma unroll
      for (int j = 0; j < 3; ++j) { wg[j] = *(const f32x4*)(cw + j * 2 * DFF + 4 * q); wv[j] = *(const f32x4*)(cw + j * 2 * DFF + DFF + 4 * q); }
      bg = *(const f32x4*)(cbp + 4 * q); bv = *(const f32x4*)(cbp + DFF + 4 * q);
#pragma unroll
      for (int ai = 0; ai < 2; ++ai) {
        int base, L, t0; halo_block(u.pm * 4 + ai * 2 + wr, base, L, t0);
#pragma unroll
        for (int m = 0; m < 4; ++m) {
          const int r = m * 16 + fr, t = t0 + r;
          const int mp = m > 0 ? m - 1 : 0, mn = m < 3 ? m + 1 : 3;
          f32x4 o;
#pragma unroll
          for (int j = 0; j < 4; ++j) {
            const float gc = acc[ai][0][m][q][j], vc = acc[ai][1][m][q][j];
            const float gp = dpp_ror1(fr == 15 ? acc[ai][0][mp][q][j] : gc), gn = dpp_ror15(fr == 0 ? acc[ai][0][mn][q][j] : gc);
            const float vp = dpp_ror1(fr == 15 ? acc[ai][1][mp][q][j] : vc), vn = dpp_ror15(fr == 0 ? acc[ai][1][mn][q][j] : vc);
            const float gg = wg[0][j] * gp + wg[1][j] * gc + wg[2][j] * gn + bg[j];
            const float vv = wv[0][j] * vp + wv[1][j] * vc + wv[2][j] * vn + bv[j];
            o[j] = gg * __builtin_amdgcn_rcpf(1.f + __expf(-gg)) * vv;
          }
          if (r >= 1 && r <= 62 && t < L)
            *(u32x2*)((char*)p.act + (unsigned)(((base + t) * DFF + f0 + 4 * q) * 2)) = mk2(pack2(o[0], o[1]), pack2(o[2], o[3]));
          __builtin_amdgcn_sched_barrier(0);
        }
      }
      __builtin_amdgcn_sched_barrier(0);
    }
  }
}

DI void attn_item(const Params& p, int layer, int item, char* smem) {
  constexpr int LDK = 136, LDV = 72;
  bf16_t* sK = (bf16_t*)smem;
  bf16_t* sV = sK + 64 * LDK;
  const int tid = tidx(), lane = tid & 63, wid = tid >> 6, l15 = lane & 15, quad = lane >> 4;
  bool isctx; int b, h, qb;
  if (item < 512) { b = item >> 6; h = (item >> 4) & 3; qb = item & 15; isctx = false; }
  else { int it = item - 512; b = it >> 3; h = (it >> 1) & 3; qb = it & 1; isctx = true; }
  const float lam_init = 0.8f - 0.6f * expf(-0.3f * (float)layer);
  float lam;
  {
    const float* lp = p.da_lambda + layer * 256;
    float a = lp[lane] * lp[64 + lane], c2 = lp[128 + lane] * lp[192 + lane];
    a = wave_sum(a); c2 = wave_sum(c2);
    lam = expf(a) - expf(c2) + lam_init;
  }
  const int qrow = (isctx ? NLAT + b * CTXL : b * SEQ) + qb * 128 + wid * 16 + l15;
  bf16x8 qf[2][2];
#pragma unroll
  for (int m = 0; m < 2; ++m)
#pragma unroll
    for (int kk = 0; kk < 2; ++kk) qf[m][kk] = *(const bf16x8*)(p.P + (size_t)qrow * PW + PC_Q + h * 128 + m * 64 + kk * 32 + quad * 8);
  const int ntile = isctx ? 4 : 36;
  const int k0_ = tid >> 4, kch = tid & 15;
  const int kpi0 = ((k0_ >> 2) & 1) * 16 + ((k0_ >> 3) & 3) * 4 + (k0_ & 3);
  const int kldsoff0 = kpi0 * LDK + kch * 8;
#define KLDS(i) (kldsoff0 + (i) * 32 * LDK)
  const long kgoff0 = (long)k0_ * PW + PC_K + h * 128 + kch * 8;
  const long kgstep = (long)32 * PW;
  const int dv0_ = tid >> 3, c8_ = tid & 7;
  const int vldsoff0 = dv0_ * LDV + c8_ * 8;
  const long vgoff0 = ((long)((b * 4 + h) * 128 + dv0_)) * NKEY + c8_ * 8;
  const long vgstep = (long)64 * NKEY;
  f32x4 oacc[2][8];
#pragma unroll
  for (int m = 0; m < 2; ++m)
#pragma unroll
    for (int t = 0; t < 8; ++t) oacc[m][t] = (f32x4){0.f, 0.f, 0.f, 0.f};
  float mrun0 = -1e30f, mrun1 = -1e30f, lsum0 = 0.f, lsum1 = 0.f;
  u32x4 rk[2], rv[2];
  {
    const bf16_t* kbase = p.P + (size_t)(NLAT + b * CTXL) * PW;
#pragma unroll
    for (int i = 0; i < 2; ++i) { rk[i] = *(const u32x4*)(kbase + kgoff0 + i * kgstep); rv[i] = *(const u32x4*)(p.Vt + vgoff0 + i * vgstep); }
  }
  constexpr int KBUF = 64 * LDK, VBUF = 128 * LDV;
  bf16_t* const sK0 = sK;
  bf16_t* const sV0 = sK + 2 * KBUF;
  const bool late = wid >= 4;
  bf16x8 pf[2][2];
#pragma unroll
  for (int m = 0; m < 2; ++m)
#pragma unroll
    for (int s_ = 0; s_ < 2; ++s_) pf[m][s_] = (bf16x8){0, 0, 0, 0, 0, 0, 0, 0};
  auto pv = [&](const bf16_t* sVx) {
#pragma unroll
    for (int s_ = 0; s_ < 2; ++s_)
#pragma unroll
      for (int t = 0; t < 8; ++t) {
        if ((t & 3) == 0) __builtin_amdgcn_sched_barrier(0);
        bf16x8 a = *(const bf16x8*)(sVx + (t * 16 + l15) * LDV + s_ * 32 + quad * 8);
        oacc[0][t] = __builtin_amdgcn_mfma_f32_16x16x32_bf16(a, pf[0][s_], oacc[0][t], 0, 0, 0);
        oacc[1][t] = __builtin_amdgcn_mfma_f32_16x16x32_bf16(a, pf[1][s_], oacc[1][t], 0, 0, 0);
      }
  };
  __syncthreads();
#pragma unroll
  for (int i = 0; i < 2; ++i) { *(u32x4*)(sK0 + KLDS(i)) = rk[i]; *(u32x4*)(sV0 + vldsoff0 + i * 64 * LDV) = rv[i]; }
  __syncthreads();
  for (int kt = 0; kt < ntile; ++kt) {
    sK = sK0 + (kt & 1) * KBUF;
    sV = sV0 + (kt % 3) * VBUF;
    if (kt + 1 < ntile) {
      int k2 = kt + 1;
      const bf16_t* kbase = (k2 < 4) ? p.P + (size_t)(NLAT + b * CTXL + k2 * 64) * PW : p.P + (size_t)(b * SEQ + (k2 - 4) * 64) * PW;
#pragma unroll
      for (int i = 0; i < 2; ++i) { rk[i] = *(const u32x4*)(kbase + kgoff0 + i * kgstep); rv[i] = *(const u32x4*)(p.Vt + vgoff0 + i * vgstep + k2 * 64); }
    }
    if (late && kt > 0) pv(sV0 + ((kt + 2) % 3) * VBUF);
    f32x4 sacc[2][4];
    __builtin_amdgcn_sched_barrier(0);
#pragma unroll
    for (int m = 0; m < 2; ++m)
#pragma unroll
      for (int tau = 0; tau < 4; ++tau) {
        f32x4 s = (f32x4){0.f, 0.f, 0.f, 0.f};
#pragma unroll
        for (int kk = 0; kk < 2; ++kk) {
          bf16x8 a = *(const bf16x8*)(sK + (tau * 16 + l15) * LDK + m * 64 + kk * 32 + quad * 8);
          s = __builtin_amdgcn_mfma_f32_16x16x32_bf16(a, qf[m][kk], s, 0, 0, 0);
        }
        sacc[m][tau] = s;
      }
    __builtin_amdgcn_sched_barrier(0);
#pragma unroll
    for (int m = 0; m < 2; ++m) {
      float mx = sacc[m][0][0];
#pragma unroll
      for (int tau = 0; tau < 4; ++tau)
#pragma unroll
        for (int j = 0; j < 4; ++j) mx = fmaxf(mx, sacc[m][tau][j]);
      {
        const auto r16 = __builtin_amdgcn_permlane16_swap(__float_as_uint(mx), __float_as_uint(mx), false, false);
        mx = fmaxf(__uint_as_float(r16[0]), __uint_as_float(r16[1]));
        const auto r32 = __builtin_amdgcn_permlane32_swap(__float_as_uint(mx), __float_as_uint(mx), false, false);
        mx = fmaxf(__uint_as_float(r32[0]), __uint_as_float(r32[1]));
      }
      const float mold = (m == 0) ? mrun0 : mrun1;
      const bool moved = __builtin_amdgcn_ballot_w64(mx > mold + 8.f) != 0ull;
      const float mnew = moved ? fmaxf(mold, mx) : mold;
      if (m == 0) mrun0 = mnew; else mrun1 = mnew;
      float ps = 0.f;
      u32x4 u0, u1;
      {
        float e0 = __builtin_amdgcn_exp2f(sacc[m][0][0] - mnew), e1 = __builtin_amdgcn_exp2f(sacc[m][0][1] - mnew), e2 = __builtin_amdgcn_exp2f(sacc[m][0][2] - mnew), e3 = __builtin_amdgcn_exp2f(sacc[m][0][3] - mnew);
        ps += (e0 + e1) + (e2 + e3); u0.x = pack2(e0, e1); u0.y = pack2(e2, e3);
      }
      {
        float e0 = __builtin_amdgcn_exp2f(sacc[m][1][0] - mnew), e1 = __builtin_amdgcn_exp2f(sacc[m][1][1] - mnew), e2 = __builtin_amdgcn_exp2f(sacc[m][1][2] - mnew), e3 = __builtin_amdgcn_exp2f(sacc[m][1][3] - mnew);
        ps += (e0 + e1) + (e2 + e3); u0.z = pack2(e0, e1); u0.w = pack2(e2, e3);
      }
      {
        float e0 = __builtin_amdgcn_exp2f(sacc[m][2][0] - mnew), e1 = __builtin_amdgcn_exp2f(sacc[m][2][1] - mnew), e2 = __builtin_amdgcn_exp2f(sacc[m][2][2] - mnew), e3 = __builtin_amdgcn_exp2f(sacc[m][2][3] - mnew);
        ps += (e0 + e1) + (e2 + e3); u1.x = pack2(e0, e1); u1.y = pack2(e2, e3);
      }
      {
        float e0 = __builtin_amdgcn_exp2f(sacc[m][3][0] - mnew), e1 = __builtin_amdgcn_exp2f(sacc[m][3][1] - mnew), e2 = __builtin_amdgcn_exp2f(sacc[m][3][2] - mnew), e3 = __builtin_amdgcn_exp2f(sacc[m][3][3] - mnew);
        ps += (e0 + e1) + (e2 + e3); u1.z = pack2(e0, e1); u1.w = pack2(e2, e3);
      }
      if (moved) {
        const float alpha = __builtin_amdgcn_exp2f(mold - mnew);
        if (m == 0) lsum0 *= alpha; else lsum1 *= alpha;
#pragma unroll
        for (int t = 0; t < 8; ++t) { oacc[m][t][0] *= alpha; oacc[m][t][1] *= alpha; oacc[m][t][2] *= alpha; oacc[m][t][3] *= alpha; }
      }
      if (m == 0) lsum0 += ps; else lsum1 += ps;
      pf[m][0] = __builtin_bit_cast(bf16x8, u0);
      pf[m][1] = __builtin_bit_cast(bf16x8, u1);
    }
    __builtin_amdgcn_sched_barrier(0);
    if (!late) pv(sV);
    if (kt + 1 < ntile) {
      bf16_t* nK = sK0 + ((kt + 1) & 1) * KBUF;
      bf16_t* nV = sV0 + ((kt + 1) % 3) * VBUF;
#pragma unroll
      for (int i = 0; i < 2; ++i) { *(u32x4*)(nK + KLDS(i)) = rk[i]; *(u32x4*)(nV + vldsoff0 + i * 64 * LDV) = rv[i]; }
    }
    __syncthreads();
  }
  if (late) pv(sV0 + ((ntile - 1) % 3) * VBUF);
  float l0 = lsum0, l1 = lsum1;
  l0 += __shfl_xor(l0, 16); l0 += __shfl_xor(l0, 32);
  l1 += __shfl_xor(l1, 16); l1 += __shfl_xor(l1, 32);
  const float i0 = 1.f / l0, i1 = lam / l1;
  float ss = 0.f;
#pragma unroll
  for (int t = 0; t < 8; ++t)
#pragma unroll
    for (int j = 0; j < 4; ++j) {
      float o = oacc[0][t][j] * i0 - oacc[1][t][j] * i1;
      oacc[0][t][j] = o;
      ss += o * o;
    }
  ss += __shfl_xor(ss, 16); ss += __shfl_xor(ss, 32);
  const float rstd = rsqrtf(ss * (1.f / 128.f) + 1e-6f) * (1.f - lam_init);
  const float* sg = p.da_subln_g + layer * 128;
#pragma unroll
  for (int t = 0; t < 8; ++t) {
    int dv = t * 16 + quad * 4;
    float4 g = *(const float4*)(sg + dv);
    *(u32x2*)(p.Abuf + (size_t)qrow * D + h * 128 + dv) =
        mk2(pack2(oacc[0][t][0] * rstd * g.x, oacc[0][t][1] * rstd * g.y), pack2(oacc[0][t][2] * rstd * g.z, oacc[0][t][3] * rstd * g.w));
  }
}

DI float red16(float v) {
  v += __int_as_float(__builtin_amdgcn_update_dpp(0, __float_as_int(v), 0xB1, 0xF, 0xF, true));
  v += __int_as_float(__builtin_amdgcn_update_dpp(0, __float_as_int(v), 0x4E, 0xF, 0xF, true));
  v += __int_as_float(__builtin_amdgcn_update_dpp(0, __float_as_int(v), 0x141, 0xF, 0xF, true));
  v += __int_as_float(__builtin_amdgcn_update_dpp(0, __float_as_int(v), 0x140, 0xF, 0xF, true));
  return v;
}
DI float red8(float v) {
  v += __int_as_float(__builtin_amdgcn_update_dpp(0, __float_as_int(v), 0xB1, 0xF, 0xF, true));
  v += __int_as_float(__builtin_amdgcn_update_dpp(0, __float_as_int(v), 0x4E, 0xF, 0xF, true));
  v += __int_as_float(__builtin_amdgcn_update_dpp(0, __float_as_int(v), 0x141, 0xF, 0xF, true));
  return v;
}
constexpr int SC2_Q = 0, SC2_K = 2048, SC2_V = 4096, SC2_A = 6144, SC2_O = 6272, SC2_BUF = 8320;
template <int MX>
DI void scan_item(const Params& p, int layer, int dir, int b, int h, float* sm) {
  const int tfull = tidx();
  const bool stager = tfull >= 256;
  const int tid = tfull & 255;
  const int e = tid >> 2, part = tid & 3;
  const int pl = tid >> 3, p8 = tid & 7;
  const int slot_w = dir == 0 ? pl : 31 - pl;
  f32x2 s2[8];
#pragma unroll
  for (int d = 0; d < 8; ++d) s2[d] = (f32x2){0.f, 0.f};
  float lbf[8], oml[8];
  float gA = 0.f, gdt = 0.f;
  if (MX == 0) {
#pragma unroll
    for (int d = 0; d < 8; ++d) {
      float lb = 0.f;
      if (layer == 1) {
        int ci = dir * 256 + h * 64 + p8 * 8 + d;
        float l0 = p.hg_lb_logits[ci], l1 = p.hg_lb_logits[512 + ci];
        lb = 1.f / (1.f + expf(l0 - l1));
      }
      lbf[d] = fmaxf(lb, 1e-30f);
      oml[d] = 1.f - lb;
    }
  } else {
    gA = expf(p.gd_a_log[layer * 8 + dir * 4 + h]);
    gdt = p.gd_dt_bias[layer * 8 + dir * 4 + h];
  }
  const float* cw = p.gd_conv_w + (size_t)layer * 3 * 768;
  u32x4 rq[3], rk[3], rv[3];
  float ra_ = 0.f, rb_ = 0.f;
  const u32x4 z4 = {0u, 0u, 0u, 0u};
#pragma unroll
  for (int j = 0; j < 3; ++j) { rq[j] = z4; rk[j] = z4; rv[j] = z4; }

#define SCAN_CHUNK_GEOM(c)                                                   \
  const int seg_ = (c) < 8 ? 0 : 1;                                          \
  const int L_ = seg_ == 0 ? CTXL : SEQ;                                     \
  const int rowbase_ = seg_ == 0 ? NLAT + b * CTXL : b * SEQ;                \
  const int ci_ = seg_ == 0 ? (c) : (c) - 8;                                 \
  const int p0_ = dir == 0 ? ci_ * 32 : L_ - 32 * (ci_ + 1);

  auto load_raw = [&](int c) {
    SCAN_CHUNK_GEOM(c)
    const int pos = p0_ + pl;
    const bf16_t* prow = p.P + (size_t)(rowbase_ + pos) * PW;
    if (MX == 0) {
      rq[0] = *(const u32x4*)(prow + PC_HQ + h * 64 + p8 * 8);
      rk[0] = *(const u32x4*)(prow + PC_HF + dir * 256 + h * 64 + p8 * 8);
      rv[0] = *(const u32x4*)(prow + PC_HI + h * 64 + p8 * 8);
    } else {
#pragma unroll
      for (int j = 0; j < 3; ++j) {
        const int pp = pos + j - 1;
        const bool ok = (pp >= 0 && pp < L_);
        const bf16_t* pr = p.P + (size_t)(rowbase_ + pp) * PW + PC_GQKV + h * 64 + p8 * 8;
        rq[j] = ok ? *(const u32x4*)(pr) : z4;
        rk[j] = ok ? *(const u32x4*)(pr + 256) : z4;
        rv[j] = ok ? *(const u32x4*)(pr + 512) : z4;
      }
      if (p8 == 0) { ra_ = bf2f(prow[PC_GA + dir * 4 + h]); rb_ = bf2f(prow[PC_GB + dir * 4 + h]); }
    }
  };
  auto compute_store = [&](float* buf) {
    float* sq = buf + SC2_Q + slot_w * 64 + p8 * 8;
    float* sk = buf + SC2_K + slot_w * 64 + p8 * 8;
    float* sv = buf + SC2_V + slot_w * 64 + p8 * 8;
    if (MX == 0) {
      float qv[8], fv[8], iv[8];
      unpack8(rq[0], qv); unpack8(rk[0], fv); unpack8(rv[0], iv);
      f32x4 o0, o1, f0, f1;
#pragma unroll
      for (int d = 0; d < 4; ++d) {
        o0[d] = qv[d] * __builtin_amdgcn_rcpf(1.f + __expf(-qv[d])); o1[d] = qv[4 + d] * __builtin_amdgcn_rcpf(1.f + __expf(-qv[4 + d]));
        f0[d] = lbf[d] + oml[d] * __builtin_amdgcn_rcpf(1.f + __expf(-fv[d])); f1[d] = lbf[4 + d] + oml[4 + d] * __builtin_amdgcn_rcpf(1.f + __expf(-fv[4 + d]));
      }
      *(f32x4*)(sq) = o0; *(f32x4*)(sq + 4) = o1;
      *(f32x4*)(sk) = f0; *(f32x4*)(sk + 4) = f1;
      const f32x4 v0 = {iv[0], iv[1], iv[2], iv[3]}, v1 = {iv[4], iv[5], iv[6], iv[7]};
      *(f32x4*)(sv) = v0; *(f32x4*)(sv + 4) = v1;
    } else {
      float yq[8], yk[8], yv[8];
#pragma unroll
      for (int d = 0; d < 8; ++d) { yq[d] = 0.f; yk[d] = 0.f; yv[d] = 0.f; }
#pragma unroll
      for (int j = 0; j < 3; ++j) {
        float xq[8], xk[8], xv[8];
        unpack8(rq[j], xq); unpack8(rk[j], xk); unpack8(rv[j], xv);
        const float* cq = cw + j * 768 + h * 64 + p8 * 8;
        const f32x4 wq0 = *(const f32x4*)(cq), wq1 = *(const f32x4*)(cq + 4);
        const f32x4 wk0 = *(const f32x4*)(cq + 256), wk1 = *(const f32x4*)(cq + 260);
        const f32x4 wv0 = *(const f32x4*)(cq + 512), wv1 = *(const f32x4*)(cq + 516);
#pragma unroll
        for (int d = 0; d < 4; ++d) {
          yq[d] += xq[d] * wq0[d]; yq[4 + d] += xq[4 + d] * wq1[d];
          yk[d] += xk[d] * wk0[d]; yk[4 + d] += xk[4 + d] * wk1[d];
          yv[d] += xv[d] * wv0[d]; yv[4 + d] += xv[4 + d] * wv1[d];
        }
      }
      float sq2 = 0.f, sk2 = 0.f;
#pragma unroll
      for (int d = 0; d < 8; ++d) {
        yq[d] = yq[d] * __builtin_amdgcn_rcpf(1.f + __expf(-yq[d]));
        yk[d] = yk[d] * __builtin_amdgcn_rcpf(1.f + __expf(-yk[d]));
        yv[d] = yv[d] * __builtin_amdgcn_rcpf(1.f + __expf(-yv[d]));
        sq2 += yq[d] * yq[d]; sk2 += yk[d] * yk[d];
      }
      sq2 = red8(sq2); sk2 = red8(sk2);
      const float rqn = rsqrtf(sq2 + 1e-6f) * 0.125f, rkn = rsqrtf(sk2 + 1e-6f);
      float qk = 0.f;
      f32x4 o0, o1, k0, k1;
#pragma unroll
      for (int d = 0; d < 4; ++d) {
        o0[d] = yq[d] * rqn; o1[d] = yq[4 + d] * rqn; k0[d] = yk[d] * rkn; k1[d] = yk[4 + d] * rkn;
        qk += o0[d] * k0[d] + o1[d] * k1[d];
      }
      qk = red8(qk);
      *(f32x4*)(sq) = o0; *(f32x4*)(sq + 4) = o1;
      *(f32x4*)(sk) = k0; *(f32x4*)(sk + 4) = k1;
      const f32x4 v0 = {yv[0], yv[1], yv[2], yv[3]}, v1 = {yv[4], yv[5], yv[6], yv[7]};
      *(f32x4*)(sv) = v0; *(f32x4*)(sv + 4) = v1;
      if (p8 == 0) {
        const float xx = ra_ + gdt;
        const float y = __expf(xx);
        const float sp = xx > 15.f ? xx : (y < 1e-3f ? y * (1.f - 0.5f * y) : __logf(1.f + y));
        const f32x4 rec = {__expf(-gA * sp), __builtin_amdgcn_rcpf(1.f + __expf(-rb_)), qk, 0.f};
        *(f32x4*)(buf + SC2_A + slot_w * 4) = rec;
      }
    }
  };
  auto write_out = [&](int c) {
    SCAN_CHUNK_GEOM(c)
    const float* so = sm + (c & 1) * SC2_BUF + SC2_O + slot_w * 64 + p8 * 8;
    const f32x4 a0 = *(const f32x4*)so, a1 = *(const f32x4*)(so + 4);
    bf16_t* dst = p.raw + ((size_t)((MX * 2 + dir) * NROW + rowbase_ + p0_ + pl)) * 256 + h * 64 + p8 * 8;
    *(u32x4*)dst = mk4(pack2(a0[0], a0[1]), pack2(a0[2], a0[3]), pack2(a1[0], a1[1]), pack2(a1[2], a1[3]));
  };

  constexpr int NCH = 8 + 64;
  __syncthreads();
  if (stager) { load_raw(0); compute_store(sm); }
  __syncthreads();
  if (!stager) __builtin_amdgcn_s_setprio(3);
  for (int c = 0; c < NCH; ++c) {
    if (stager) {
      if (c + 1 < NCH) load_raw(c + 1);
      if (c > 0) write_out(c - 1);
      if (c + 1 < NCH) compute_store(sm + ((c + 1) & 1) * SC2_BUF);
    } else {
      const float* buf = sm + (c & 1) * SC2_BUF;
      const float* sq = buf + SC2_Q + part * 16;
      const float* sk = buf + SC2_K + part * 16;
      const float* sv = buf + SC2_V + e;
      const float* sa = buf + SC2_A;
      float* so = sm + (c & 1) * SC2_BUF + SC2_O + e;
      f32x4 qn[4], kn[4];
      float vnx;
      f32x4 recn = {0.f, 0.f, 0.f, 0.f};
#pragma unroll
      for (int u = 0; u < 4; ++u) { qn[u] = *(const f32x4*)(sq + 4 * u); kn[u] = *(const f32x4*)(sk + 4 * u); }
      vnx = sv[0];
      if (MX == 1) recn = *(const f32x4*)(sa);
#pragma unroll
      for (int i = 0; i < 32; ++i) {
        f32x4 q[4], k[4];
#pragma unroll
        for (int u = 0; u < 4; ++u) { q[u] = qn[u]; k[u] = kn[u]; }
        const float vv = vnx;
        const f32x4 rec = recn;
        const int il = (i < 31) ? i + 1 : i;
#pragma unroll
        for (int u = 0; u < 4; ++u) { qn[u] = *(const f32x4*)(sq + il * 64 + 4 * u); kn[u] = *(const f32x4*)(sk + il * 64 + 4 * u); }
        vnx = sv[il * 64];
        if (MX == 1) recn = *(const f32x4*)(sa + il * 4);
        float o;
        if (MX == 0) {
          const f32x2 vv2 = {vv, vv};
          f32x2 acc2 = {0.f, 0.f};
#pragma unroll
          for (int u = 0; u < 4; ++u) {
            const f32x2 klo = {k[u][0], k[u][1]}, khi = {k[u][2], k[u][3]};
            const f32x2 qlo = {q[u][0], q[u][1]}, qhi = {q[u][2], q[u][3]};
            s2[2 * u] = vv2 + klo * (s2[2 * u] - vv2);
            s2[2 * u + 1] = vv2 + khi * (s2[2 * u + 1] - vv2);
            acc2 += s2[2 * u] * qlo;
            acc2 += s2[2 * u + 1] * qhi;
          }
          o = quad_sum(acc2[0] + acc2[1]);
        } else {
          const float al = rec[0], be = rec[1], qk = rec[2];
          f32x2 ks2 = {0.f, 0.f}, qs2 = {0.f, 0.f};
#pragma unroll
          for (int u = 0; u < 4; ++u) {
            const f32x2 klo = {k[u][0], k[u][1]}, khi = {k[u][2], k[u][3]};
            const f32x2 qlo = {q[u][0], q[u][1]}, qhi = {q[u][2], q[u][3]};
            ks2 += klo * s2[2 * u]; ks2 += khi * s2[2 * u + 1];
            qs2 += qlo * s2[2 * u]; qs2 += qhi * s2[2 * u + 1];
          }
          const float ks = quad_sum(ks2[0] + ks2[1]), qs = quad_sum(qs2[0] + qs2[1]);
          const float vn = be * (vv - al * ks);
          const f32x2 al2 = {al, al}, vn2 = {vn, vn};
#pragma unroll
          for (int u = 0; u < 4; ++u) {
            const f32x2 klo = {k[u][0], k[u][1]}, khi = {k[u][2], k[u][3]};
            s2[2 * u] = al2 * s2[2 * u] + klo * vn2;
            s2[2 * u + 1] = al2 * s2[2 * u + 1] + khi * vn2;
          }
          o = al * qs + qk * vn;
        }
        so[i * 64] = o;
      }
    }
    __syncthreads();
  }
  __builtin_amdgcn_s_setprio(0);
  if (stager) write_out(NCH - 1);
}

constexpr int GD_QK = 4224;
constexpr int GD_V = 3 * GD_QK;
constexpr int GD_VNT = GD_V + 2 * 2048;
constexpr int GD_S0 = GD_VNT + 2 * 2048;
constexpr int GD_GC = GD_S0 + 2 * 2048;
constexpr int GD_QKB = GD_GC + 128;
DI bf16x8 cvt8(const f32x4 a, const f32x4 b) {
  const u32x4 u = mk4(pack2(a[0], a[1]), pack2(a[2], a[3]), pack2(b[0], b[1]), pack2(b[2], b[3]));
  return __builtin_bit_cast(bf16x8, u);
}
DI void scan_item_gdn(const Params& p, int layer, int dir, int b, int h, float* sm) {
  const int tfull = tidx();
  const bool stager = tfull >= 256;
  const int tid = tfull & 255;
  const int e = tid >> 2, part = tid & 3;
  const int pl = tid >> 3, p8 = tid & 7;
  const int slot_w = dir == 0 ? pl : 31 - pl;
  const int sw = tid >> 6, lane = tid & 63, l15 = lane & 15, g = lane >> 4;
  f32x2 s2[8];
#pragma unroll
  for (int d = 0; d < 8; ++d) s2[d] = (f32x2){0.f, 0.f};
  const float gA = expf(p.gd_a_log[layer * 8 + dir * 4 + h]);
  const float gdt = p.gd_dt_bias[layer * 8 + dir * 4 + h];
  const float* cw = p.gd_conv_w + (size_t)layer * 3 * 768;
  u32x4 rq[3], rk[3], rv[3];
  float ra_ = 0.f, rb_ = 0.f;
  const u32x4 z4 = {0u, 0u, 0u, 0u};
#pragma unroll
  for (int j = 0; j < 3; ++j) { rq[j] = z4; rk[j] = z4; rv[j] = z4; }

#define GDN_CHUNK_GEOM(c)                                                    \
  const int seg_ = (c) < 8 ? 0 : 1;                                          \
  const int L_ = seg_ == 0 ? CTXL : SEQ;                                     \
  const int rowbase_ = seg_ == 0 ? NLAT + b * CTXL : b * SEQ;                \
  const int ci_ = seg_ == 0 ? (c) : (c) - 8;                                 \
  const int p0_ = dir == 0 ? ci_ * 32 : L_ - 32 * (ci_ + 1);

  auto load_raw = [&](int c) {
    GDN_CHUNK_GEOM(c)
    const int pos = p0_ + pl;
    const bf16_t* prow = p.P + (size_t)(rowbase_ + pos) * PW;
#pragma unroll
    for (int j = 0; j < 3; ++j) {
      const int pp = pos + j - 1;
      const bool ok = (pp >= 0 && pp < L_);
      const bf16_t* pr = p.P + (size_t)(rowbase_ + pp) * PW + PC_GQKV + h * 64 + p8 * 8;
      rq[j] = ok ? *(const u32x4*)(pr) : z4;
      rk[j] = ok ? *(const u32x4*)(pr + 256) : z4;
      rv[j] = ok ? *(const u32x4*)(pr + 512) : z4;
    }
    if (p8 == 0) { ra_ = bf2f(prow[PC_GA + dir * 4 + h]); rb_ = bf2f(prow[PC_GB + dir * 4 + h]); }
  };
  auto compute_store = [&](int c) {
    float* qk = sm + (c % 3) * GD_QK;
    float* sq = qk + slot_w * 64 + p8 * 8;
    float* sk = qk + 2048 + slot_w * 64 + p8 * 8;
    float* sv = sm + GD_V + (c & 1) * 2048 + slot_w * 64 + p8 * 8;
    float yq[8], yk[8], yv[8];
#pragma unroll
    for (int d = 0; d < 8; ++d) { yq[d] = 0.f; yk[d] = 0.f; yv[d] = 0.f; }
#pragma unroll
    for (int j = 0; j < 3; ++j) {
      float xq[8], xk[8], xv[8];
      unpack8(rq[j], xq); unpack8(rk[j], xk); unpack8(rv[j], xv);
      const float* cq = cw + j * 768 + h * 64 + p8 * 8;
      const f32x4 wq0 = *(const f32x4*)(cq), wq1 = *(const f32x4*)(cq + 4);
      const f32x4 wk0 = *(const f32x4*)(cq + 256), wk1 = *(const f32x4*)(cq + 260);
      const f32x4 wv0 = *(const f32x4*)(cq + 512), wv1 = *(const f32x4*)(cq + 516);
#pragma unroll
      for (int d = 0; d < 4; ++d) {
        yq[d] += xq[d] * wq0[d]; yq[4 + d] += xq[4 + d] * wq1[d];
        yk[d] += xk[d] * wk0[d]; yk[4 + d] += xk[4 + d] * wk1[d];
        yv[d] += xv[d] * wv0[d]; yv[4 + d] += xv[4 + d] * wv1[d];
      }
    }
    float sq2 = 0.f, sk2 = 0.f;
#pragma unroll
    for (int d = 0; d < 8; ++d) {
      yq[d] = yq[d] * __builtin_amdgcn_rcpf(1.f + __expf(-yq[d]));
      yk[d] = yk[d] * __builtin_amdgcn_rcpf(1.f + __expf(-yk[d]));
      yv[d] = yv[d] * __builtin_amdgcn_rcpf(1.f + __expf(-yv[d]));
      sq2 += yq[d] * yq[d]; sk2 += yk[d] * yk[d];
    }
    sq2 = red8(sq2); sk2 = red8(sk2);
    const float rqn = rsqrtf(sq2 + 1e-6f) * 0.125f, rkn = rsqrtf(sk2 + 1e-6f);
    f32x4 o0, o1, k0, k1;
#pragma unroll
    for (int d = 0; d < 4; ++d) { o0[d] = yq[d] * rqn; o1[d] = yq[4 + d] * rqn; k0[d] = yk[d] * rkn; k1[d] = yk[4 + d] * rkn; }
    *(f32x4*)(sq) = o0; *(f32x4*)(sq + 4) = o1;
    *(f32x4*)(sk) = k0; *(f32x4*)(sk + 4) = k1;
    {
      bf16_t* qkb = (bf16_t*)(sm + GD_QKB + (c % 3) * 2048);
      *(bf16x8*)(qkb + slot_w * 64 + p8 * 8) = cvt8(o0, o1);
      *(bf16x8*)(qkb + 2048 + slot_w * 64 + p8 * 8) = cvt8(k0, k1);
    }
    const f32x4 v0 = {yv[0], yv[1], yv[2], yv[3]}, v1 = {yv[4], yv[5], yv[6], yv[7]};
    *(f32x4*)(sv) = v0; *(f32x4*)(sv + 4) = v1;
    if (p8 == 0) {
      const float xx = ra_ + gdt;
      const float y = __expf(xx);
      const float sp = xx > 15.f ? xx : (y < 1e-3f ? y * (1.f - 0.5f * y) : __logf(1.f + y));
      const float la = fmaxf(-gA * sp * 1.4426950408889634f, -115.f);
      const f32x4 rec = {__expf(-gA * sp), __builtin_amdgcn_rcpf(1.f + __expf(-rb_)), la, 0.f};
      *(f32x4*)(qk + 4096 + slot_w * 4) = rec;
    }
  };
  auto output = [&](int c) {
    GDN_CHUNK_GEOM(c)
    const float* qk = sm + (c % 3) * GD_QK;
    const float* sq = qk;
    const float* sk = qk + 2048;
    const float* rec = qk + 4096;
    const float* vnt = sm + GD_VNT + (c & 1) * 2048;
    const bf16_t* s0t = (const bf16_t*)(sm + GD_S0 + (c & 1) * 2048);
    float* gcs = sm + GD_GC + sw * 32;
    {
      float x = (lane < 32) ? rec[lane * 4 + 2] : 0.f;
#pragma unroll
      for (int off = 1; off < 32; off <<= 1) { const float t = __shfl_up(x, off); if (lane >= off) x += t; }
      if (lane < 32) gcs[lane] = x;
    }
    const float gct0 = gcs[l15], gct1 = gcs[16 + l15];
    const float eg0 = __builtin_amdgcn_exp2f(gct0), eg1 = __builtin_amdgcn_exp2f(gct1);
    const bf16_t* qb = (const bf16_t*)(sm + GD_QKB + (c % 3) * 2048);
    const bf16_t* kb = qb + 2048;
    bf16x8 qf[2][2];
#pragma unroll
    for (int n = 0; n < 2; ++n)
#pragma unroll
      for (int kk = 0; kk < 2; ++kk) qf[n][kk] = *(const bf16x8*)(qb + (16 * n + l15) * 64 + 32 * kk + 8 * g);
    f32x4 acc[2];
#pragma unroll
    for (int n = 0; n < 2; ++n) acc[n] = (f32x4){0.f, 0.f, 0.f, 0.f};
#pragma unroll
    for (int kk = 0; kk < 2; ++kk) {
      const bf16x8 a = *(const bf16x8*)(s0t + (16 * sw + l15) * 64 + 32 * kk + 8 * g);
      acc[0] = __builtin_amdgcn_mfma_f32_16x16x32_bf16(a, qf[0][kk], acc[0], 0, 0, 0);
      acc[1] = __builtin_amdgcn_mfma_f32_16x16x32_bf16(a, qf[1][kk], acc[1], 0, 0, 0);
    }
    acc[0] *= eg0; acc[1] *= eg1;
    f32x4 wt[2][2];
#pragma unroll
    for (int m = 0; m < 2; ++m)
#pragma unroll
      for (int n = 0; n < 2; ++n) wt[m][n] = (f32x4){0.f, 0.f, 0.f, 0.f};
#pragma unroll
    for (int m = 0; m < 2; ++m)
#pragma unroll
      for (int kk = 0; kk < 2; ++kk) {
        const bf16x8 a = *(const bf16x8*)(kb + (16 * m + l15) * 64 + 32 * kk + 8 * g);
        if (m == 0) wt[0][0] = __builtin_amdgcn_mfma_f32_16x16x32_bf16(a, qf[0][kk], wt[0][0], 0, 0, 0);
        wt[m][1] = __builtin_amdgcn_mfma_f32_16x16x32_bf16(a, qf[1][kk], wt[m][1], 0, 0, 0);
      }
#pragma unroll
    for (int m = 0; m < 2; ++m) {
      const f32x4 gs = *(const f32x4*)(gcs + 16 * m + 4 * g);
#pragma unroll
      for (int n = 0; n < 2; ++n) {
        if (m == 1 && n == 0) continue;
        const float gt = n == 0 ? gct0 : gct1;
        const int t = 16 * n + l15;
#pragma unroll
        for (int j = 0; j < 4; ++j) {
          const int s_ = 16 * m + 4 * g + j;
          wt[m][n][j] = (s_ <= t) ? wt[m][n][j] * __builtin_amdgcn_exp2f(gt - gs[j]) : 0.f;
        }
      }
    }
    {
      const float* vsrc = vnt + (16 * sw + l15) * 32 + 4 * g;
      const bf16x8 a = cvt8(*(const f32x4*)vsrc, *(const f32x4*)(vsrc + 16));
#pragma unroll
      for (int n = 0; n < 2; ++n) {
        const bf16x8 bw = cvt8(wt[0][n], wt[1][n]);
        acc[n] = __builtin_amdgcn_mfma_f32_16x16x32_bf16(a, bw, acc[n], 0, 0, 0);
      }
    }
#pragma unroll
    for (int n = 0; n < 2; ++n) {
      const int t = 16 * n + l15;
      const int pos = p0_ + (dir == 0 ? t : 31 - t);
      bf16_t* dst = p.raw + ((size_t)((1 * 2 + dir) * NROW + rowbase_ + pos)) * 256 + h * 64 + 16 * sw + 4 * g;
      *(u32x2*)dst = mk2(pack2(acc[n][0], acc[n][1]), pack2(acc[n][2], acc[n][3]));
    }
  };

  constexpr int NCH = 8 + 64;
  __syncthreads();
  if (stager) { load_raw(0); compute_store(0); }
  __syncthreads();
  if (!stager) __builtin_amdgcn_s_setprio(3);
  for (int c = 0; c < NCH; ++c) {
    if (stager) {
      if (c + 1 < NCH) load_raw(c + 1);
      if (c > 0) output(c - 1);
      if (c + 1 < NCH) compute_store(c + 1);
    } else {
      const float* qk = sm + (c % 3) * GD_QK;
      const float* sq = qk + part * 16;
      const float* sk = qk + 2048 + part * 16;
      const float* sa = qk + 4096;
      const float* sv = sm + GD_V + (c & 1) * 2048 + e;
      float* vnt = sm + GD_VNT + (c & 1) * 2048 + e * 32;
      {
        bf16_t* s0 = (bf16_t*)(sm + GD_S0 + (c & 1) * 2048) + e * 64 + part * 16;
        *(u32x4*)s0 = mk4(pack2(s2[0][0], s2[0][1]), pack2(s2[1][0], s2[1][1]), pack2(s2[2][0], s2[2][1]), pack2(s2[3][0], s2[3][1]));
        *(u32x4*)(s0 + 8) = mk4(pack2(s2[4][0], s2[4][1]), pack2(s2[5][0], s2[5][1]), pack2(s2[6][0], s2[6][1]), pack2(s2[7][0], s2[7][1]));
      }
      f32x4 kn[4];
      float vnx;
      f32x4 recn;
#pragma unroll
      for (int u = 0; u < 4; ++u) kn[u] = *(const f32x4*)(sk + 4 * u);
      vnx = sv[0];
      recn = *(const f32x4*)(sa);
#pragma unroll
      for (int i = 0; i < 32; ++i) {
        f32x4 k[4];
#pragma unroll
        for (int u = 0; u < 4; ++u) k[u] = kn[u];
        const float vv = vnx;
        const f32x4 rec = recn;
        const int il = (i < 31) ? i + 1 : i;
#pragma unroll
        for (int u = 0; u < 4; ++u) kn[u] = *(const f32x4*)(sk + il * 64 + 4 * u);
        vnx = sv[il * 64];
        recn = *(const f32x4*)(sa + il * 4);
        const float al = rec[0], be = rec[1];
        f32x2 ks2 = {0.f, 0.f};
#pragma unroll
        for (int u = 0; u < 4; ++u) {
          const f32x2 klo = {k[u][0], k[u][1]}, khi = {k[u][2], k[u][3]};
          ks2 += klo * s2[2 * u]; ks2 += khi * s2[2 * u + 1];
        }
        const float ks = quad_sum(ks2[0] + ks2[1]);
        const float vn = be * (vv - al * ks);
        const f32x2 al2 = {al, al}, vn2 = {vn, vn};
#pragma unroll
        for (int u = 0; u < 4; ++u) {
          const f32x2 klo = {k[u][0], k[u][1]}, khi = {k[u][2], k[u][3]};
          s2[2 * u] = al2 * s2[2 * u] + klo * vn2;
          s2[2 * u + 1] = al2 * s2[2 * u + 1] + khi * vn2;
        }
        vnt[i] = vn;
      }
      (void)sq;
    }
    __syncthreads();
  }
  __builtin_amdgcn_s_setprio(0);
  if (stager) output(NCH - 1);
}

DI void finish_phase(const Params& p, int layer) {
  const int lane = tidx() & 63, wid = tidx() >> 6;
  const int nrows = (layer == 1) ? NLAT : NROW;
  for (int idx = bidx() * NWAVE + wid; idx < nrows * 2; idx += gridDim.x * NWAVE) {
    const int row = idx >> 1, mx = idx & 1;
    u32x2 uf = __builtin_nontemporal_load((const u32x2*)(p.raw + ((size_t)((mx * 2 + 0) * NROW + row)) * 256 + lane * 4));
    u32x2 ub = __builtin_nontemporal_load((const u32x2*)(p.raw + ((size_t)((mx * 2 + 1) * NROW + row)) * 256 + lane * 4));
    float o[4];
    o[0] = __uint_as_float(uf.x << 16) + __uint_as_float(ub.x << 16);
    o[1] = __uint_as_float(uf.x & 0xffff0000u) + __uint_as_float(ub.x & 0xffff0000u);
    o[2] = __uint_as_float(uf.y << 16) + __uint_as_float(ub.y << 16);
    o[3] = __uint_as_float(uf.y & 0xffff0000u) + __uint_as_float(ub.y & 0xffff0000u);
    float ss = o[0] * o[0] + o[1] * o[1] + o[2] * o[2] + o[3] * o[3];
    ss += __shfl_xor(ss, 1); ss += __shfl_xor(ss, 2); ss += __shfl_xor(ss, 4); ss += __shfl_xor(ss, 8);
    const float rstd = rsqrtf(ss * (1.f / 64.f) + 1e-6f);
    u32x2 ug = *(const u32x2*)(p.P + (size_t)row * PW + (mx == 0 ? PC_HG : PC_GG) + lane * 4);
    float g[4] = {__uint_as_float(ug.x << 16), __uint_as_float(ug.x & 0xffff0000u), __uint_as_float(ug.y << 16), __uint_as_float(ug.y & 0xffff0000u)};
    const float* ng = (mx == 0 ? p.hg_norm_g : p.gd_norm_g) + layer * 64 + (lane & 15) * 4;
    float r[4];
#pragma unroll
    for (int j = 0; j < 4; ++j) r[j] = (o[j] * rstd * ng[j]) * silu_f(g[j]);
    *(u32x2*)(p.Abuf + (size_t)row * D + 512 + mx * 256 + lane * 4) = mk2(pack2(r[0], r[1]), pack2(r[2], r[3]));
  }
}

DI void run_phase(const Params& p, int ph, char* smem) {
  const int bid = bidx(), G = gridDim.x;
  LAS unsigned char* lds = (LAS unsigned char*)smem;
  if (ph == 0) {
    for (int pr = bid; pr < (WT_IN + 1) / 2; pr += G) weight_pair(p, 0, 0, WT_IN, pr, smem);
    for (int it = bid; it < 192; it += G) mod_item(p, it, (float*)smem);
    for (int it = bid; it < 64; it += G) rope_item(p, it);
    if (bid == G - 1) for (int i = tidx(); i < D / 2; i += NTHR) ((unsigned*)(p.Abuf + (size_t)NROW * D))[i] = 0u;
    return;
  }
  int layer, code;
  if (ph == 1) { layer = 0; code = 10; }
  else if (ph < 12) { layer = 0; code = ph - 2; }
  else { layer = 1; const int q = ph - 12; code = q < 5 ? q : q + 1; if (code == 9) code = 8; }
  bool do_mix = false, do_upd = false;
  const bf16_t* gA = nullptr; const bf16_t* gB = nullptr; int gK = 0, gnM = 0, gpm = 0, gG = 0, gc = 0;
  int uwhich = 0, umode = 0, ubofs = 0, unb = G;
  switch (code) {
    case 10: do_upd = true; uwhich = 0; break;
    case 0: {
      gemm_phase<EPI_P, 0>(p, layer, lds, p.Abuf, p.WinT, D, NROW / 256, INW / 256);
      gemm_phase<EPI_VT, 0>(p, layer, lds, p.WvT, p.Abuf, D, 2, NROW / 256);
      if (G == 256 && bid >= 144) for (int k = 0; k < WPRE / 112; ++k) weight_pair(p, layer, WT_IN, WT_ITEMS, (bid - 144) + k * 112, smem);
    } break;
    case 1: {
      const int nattn = (layer == 0) ? 512 + 64 : 512;
      const int wpre = (G == 256) ? WPRE : 0;
      const int nwa = (WT_ITEMS - WT_IN + 1) / 2 - wpre, nwb = (layer == 0) ? (WT_IN + 1) / 2 : 0;
      const int total = 128 + nattn + nwa + nwb;
      volatile int* slot = (volatile int*)(smem + SMEM_BYTES + 8);
#ifdef PROBE_MIX
      for (int rep = 0; rep < 2; ++rep)
#endif
      for (;;) {
        __syncthreads();
#ifdef PROBE_MIX
        if (tidx() == 0) *slot = (int)xb_add(&p.bar[XB_QUEUE(layer + 2 * rep)], 1u) + (rep == 1 && PROBE_MIX == 2 ? 128 : 0);
        __syncthreads();
        const int it = *slot;
        if (it >= ((rep == 1 && PROBE_MIX == 1) ? 128 : total)) break;
#else
        if (tidx() == 0) *slot = (int)xb_add(&p.bar[XB_QUEUE(layer)], 1u);
        __syncthreads();
        const int it = *slot;
        if (it >= total) break;
#endif
        if (it < 128) {
          const int mx = it & 1, dir = (it >> 1) & 1, h = (it >> 2) & 3, b = (it >> 4) & 7;
          if (mx == 0) scan_item<0>(p, layer, dir, b, h, (float*)smem); else scan_item_gdn(p, layer, dir, b, h, (float*)smem);
        } else if (it < 128 + nattn) attn_item(p, layer, it - 128, smem);
        else if (it < 128 + nattn + nwa) weight_pair(p, layer, WT_IN, WT_ITEMS, wpre + it - 128 - nattn, smem);
        else weight_pair(p, layer + 1, 0, WT_IN, it - 128 - nattn - nwa, smem);
      }
    } break;
    case 2: finish_phase(p, layer); break;
    case 3: do_mix = true; gA = p.Abuf; gB = p.WoutT; gK = D; gnM = NLAT / 256; break;
    case 4:
      if (layer == 0 && G > 64) {
        if (bid < 32) { do_mix = true; gA = p.Abuf; gB = p.WoutT; gK = D; gnM = NCTX / 256; gpm = NLAT / 256; gG = 32; gc = bid; }
        else { do_upd = true; uwhich = 1; umode = 1; ubofs = 32; unb = G - 32; }
      } else if (layer == 0) { do_mix = true; gA = p.Abuf; gB = p.WoutT; gK = D; gnM = NCTX / 256; gpm = NLAT / 256; }
      else { do_upd = true; uwhich = 1; }
      break;
    case 5: do_upd = true; uwhich = 1; umode = (G > 64) ? 2 : 0; break;
    case 6: gemm_phase<EPI_CONV, 1>(p, layer, lds, p.Abuf, p.WupT, D, (layer == 1) ? HB_NLAT / 4 : (HB_NLAT + HB_NCTX) / 4, 22); break;
    case 7: do_mix = true; gA = p.act; gB = p.WdownT; gK = DFF; gnM = NLAT / 256; break;
    case 8:
      if (layer == 0 && G > 64) {
        if (bid < 32) { do_mix = true; gA = p.act; gB = p.WdownT; gK = DFF; gnM = NCTX / 256; gpm = NLAT / 256; gG = 32; gc = bid; }
        else { do_upd = true; uwhich = 2; umode = 1; ubofs = 32; unb = G - 32; }
      } else if (layer == 0) { do_mix = true; gA = p.act; gB = p.WdownT; gK = DFF; gnM = NCTX / 256; gpm = NLAT / 256; }
      else { do_upd = true; uwhich = 2; }
      break;
    case 9: do_upd = true; uwhich = 2; umode = (G > 64) ? 2 : 0; break;
  }
  if (do_mix) gemm_phase<EPI_MIX, 0>(p, layer, lds, gA, gB, gK, gnM, 4, gpm, gG, gc);
  if (do_upd) update_phase(p, layer, uwhich, umode, ubofs, unb);
}

__global__ void __launch_bounds__(NTHR, 2) mega_kernel(Params p) {
  extern __shared__ __attribute__((aligned(16))) unsigned char lds_dyn[];
  char* smem = (char*)lds_dyn;
  volatile LAS unsigned* st = (volatile LAS unsigned*)((LAS unsigned char*)lds_dyn + SMEM_BYTES);
  if (threadIdx.x == 0) { st[0] = 0u; st[1] = 0u; st[2] = 0u; st[3] = 0u; }
  __syncthreads();
  XcdBarrier xb = xcd_barrier_post(p.bar, st);
  if (p.phase_end > 1000) cg::this_grid().sync();
  for (int ph = p.phase_begin; ph < p.phase_end; ++ph) {
    if (ph > p.phase_begin) xcd_barrier(xb);
    run_phase(p, ph, smem);
#ifdef PROBE_MASK
    if (ph >= 2 && ((PROBE_MASK >> ((ph - 2) & 7)) & 1)) { __syncthreads(); run_phase(p, ph, smem); }
    if (ph < 2 && (PROBE_MASK & 0x100)) { __syncthreads(); run_phase(p, ph, smem); }
#endif
  }
}

extern "C" void kernel_launch(void* const* d_in, const int* in_sizes, int n_in, void* d_out, int out_size, void* d_ws, size_t ws_size,
                              hipStream_t stream) {
  Params p{};
  p.x = (const float*)d_in[0]; p.c = (const float*)d_in[1]; p.ctx = (const float*)d_in[2]; p.c_ctx = (const float*)d_in[3];
  p.ada_w = (const float*)d_in[4]; p.ada_b = (const float*)d_in[5]; p.norm_g = (const float*)d_in[6]; p.w_in = (const float*)d_in[7];
  p.w_out = (const float*)d_in[8]; p.da_lambda = (const float*)d_in[9]; p.da_subln_g = (const float*)d_in[10];
  p.hg_lb_logits = (const float*)d_in[11]; p.hg_norm_g = (const float*)d_in[12]; p.gd_conv_w = (const float*)d_in[13];
  p.gd_a_log = (const float*)d_in[14]; p.gd_dt_bias = (const float*)d_in[15]; p.gd_norm_g = (const float*)d_in[16];
  p.ffn_w_up = (const float*)d_in[17]; p.ffn_conv_w = (const float*)d_in[18]; p.ffn_conv_b = (const float*)d_in[19];
  p.ffn_w_down = (const float*)d_in[20];
  p.out = (float*)d_out;
  char* w = (char*)d_ws;
  size_t off = 0;
  auto take = [&](size_t bytes) { char* r = w + off; off += (bytes + 255) & ~(size_t)255; return r; };
  p.WinT = (bf16_t*)take((size_t)INW * D * 2);
  p.WvT = (bf16_t*)take((size_t)512 * D * 2);
  p.WoutT = (bf16_t*)take((size_t)D * D * 2);
  p.WupT = (bf16_t*)take((size_t)2 * DFF * D * 2);
  p.WdownT = (bf16_t*)take((size_t)D * DFF * 2);
  p.mod = (float*)take((size_t)2 * 9 * 6144 * 4);
  p.ropec = (float*)take((size_t)SEQ * 32 * 4);
  p.ropes = (float*)take((size_t)SEQ * 32 * 4);
  p.cx = (float*)take((size_t)NCTX * D * 4);
  p.bar = (unsigned*)take((size_t)BAR_WORDS_TOTAL * 4);
  p.Abuf = (bf16_t*)take((size_t)(NROW + 8) * D * 2);
  char* region = w + off;
  p.P = (bf16_t*)region;
  p.Vt = (bf16_t*)(region + (size_t)NROW * PW * 2);
  p.raw = (bf16_t*)(region + (size_t)NROW * PW * 2 + (size_t)NB * 4 * 128 * NKEY * 2);
  p.mix = (bf16_t*)region;
  p.act = (bf16_t*)(region + (size_t)NROW * D * 4);

  static int grid_blocks = 0;
  if (!grid_blocks) {
    int dev = 0, cus = 0, per_cu = 0;
    (void)hipGetDevice(&dev);
    (void)hipDeviceGetAttribute(&cus, hipDeviceAttributeMultiprocessorCount, dev);
    if (hipFuncSetAttribute((const void*)mega_kernel, hipFuncAttributeMaxDynamicSharedMemorySize, LDS_TOTAL) != hipSuccess)
      fprintf(stderr, "hipFuncSetAttribute(MaxDynamicSharedMemorySize=%d) failed\n", LDS_TOTAL);
    (void)hipOccupancyMaxActiveBlocksPerMultiprocessor(&per_cu, (const void*)mega_kernel, NTHR, LDS_TOTAL);
    (void)hipGetLastError();
    grid_blocks = cus;
  }
  (void)hipMemsetAsync(p.bar, 0, (size_t)BAR_WORDS_TOTAL * 4, stream);
#ifdef MK_MULTI
  for (int ph = 0; ph < NPHASE; ++ph) {
    p.phase_begin = ph; p.phase_end = ph + 1;
    hipLaunchKernelGGL(mega_kernel, dim3(grid_blocks), dim3(NTHR), LDS_TOTAL, stream, p);
  }
#else
  p.phase_begin = 0; p.phase_end = NPHASE;
  void* args[] = {&p};
  hipError_t e = hipLaunchCooperativeKernel((void*)mega_kernel, dim3(grid_blocks), dim3(NTHR), args, LDS_TOTAL, stream);
  if (e != hipSuccess) fprintf(stderr, "cooperative launch failed: %s (grid %d)\n", hipGetErrorString(e), grid_blocks);
#endif
}
```

```cpp
#include <hip/hip_runtime.h>
#include <hip/hip_cooperative_groups.h>
#include <cstdio>
namespace cg = cooperative_groups;

typedef unsigned short bf16_t;
using bf16x8 = __attribute__((ext_vector_type(8))) short;
using f32x4 = __attribute__((ext_vector_type(4))) float;
using u32x4 = __attribute__((ext_vector_type(4))) unsigned;
using u32x2 = __attribute__((ext_vector_type(2))) unsigned;
#define DI __device__ __forceinline__
DI int tidx() { int t = threadIdx.x; asm volatile("" : "+v"(t)); return t; }
DI int bidx() { int t = blockIdx.x; asm volatile("" : "+s"(t)); return t; }
DI u32x4 mk4(unsigned a, unsigned b, unsigned c, unsigned d) { u32x4 r = {a, b, c, d}; return r; }
DI u32x2 mk2(unsigned a, unsigned b) { u32x2 r = {a, b}; return r; }

constexpr int D = 1024, NB = 8, SEQ = 2048, CTXL = 256;
constexpr int NLAT = NB * SEQ, NCTX = NB * CTXL, NROW = NLAT + NCTX;
constexpr int INC = 3856, PW = 3344, DFF = 2816, NKEY = 2304;
constexpr int PC_Q = 0, PC_K = 512, PC_HQ = 1024, PC_HI = 1280, PC_HF = 1536, PC_HG = 2048, PC_GQKV = 2304, PC_GA = 3072, PC_GB = 3080, PC_GG = 3088;
constexpr int SMEM_BYTES = 131072;
constexpr int LDS_TOTAL = SMEM_BYTES + 64;
constexpr int NTHR = 512, NWAVE = 8;
constexpr int INW = 3584;
constexpr int NPHASE = 20;

struct Params {
  const float *x, *c, *ctx, *c_ctx, *ada_w, *ada_b, *norm_g, *w_in, *w_out, *da_lambda, *da_subln_g,
      *hg_lb_logits, *hg_norm_g, *gd_conv_w, *gd_a_log, *gd_dt_bias, *gd_norm_g, *ffn_w_up, *ffn_conv_w, *ffn_conv_b, *ffn_w_down;
  float* out;
  bf16_t *WinT, *WvT, *WoutT, *WupT, *WdownT;
  float *mod, *ropec, *ropes, *cx;
  bf16_t *Abuf, *P, *Vt, *raw;
  bf16_t* mix;
  bf16_t* act;
  unsigned* bar;
  int phase_begin, phase_end;
};

typedef __bf16 hbf2 __attribute__((ext_vector_type(2)));
typedef float f32x2 __attribute__((ext_vector_type(2)));
DI unsigned pack2(float a, float b) { f32x2 v = {a, b}; hbf2 r = __builtin_convertvector(v, hbf2); return __builtin_bit_cast(unsigned, r); }
DI bf16_t f2bf(float x) { return (bf16_t)(pack2(x, x) & 0xffffu); }
DI float bf2f(bf16_t h) { return __uint_as_float(((unsigned)h) << 16); }
DI float silu_f(float x) { return x / (1.f + __expf(-x)); }
DI float sigmoid_f(float x) { return 1.f / (1.f + __expf(-x)); }
DI float quad_sum(float v) {
  int i = __float_as_int(v);
  v += __int_as_float(__builtin_amdgcn_update_dpp(0, i, 0xB1, 0xF, 0xF, true));
  i = __float_as_int(v);
  v += __int_as_float(__builtin_amdgcn_update_dpp(0, i, 0x4E, 0xF, 0xF, true));
  return v;
}
DI void unpack8(u32x4 u, float* f) {
  f[0] = __uint_as_float(u.x << 16); f[1] = __uint_as_float(u.x & 0xffff0000u);
  f[2] = __uint_as_float(u.y << 16); f[3] = __uint_as_float(u.y & 0xffff0000u);
  f[4] = __uint_as_float(u.z << 16); f[5] = __uint_as_float(u.z & 0xffff0000u);
  f[6] = __uint_as_float(u.w << 16); f[7] = __uint_as_float(u.w & 0xffff0000u);
}


#define XB_TMO      128
#define XB_XCNT(j)  (256  + 64 * (j))
#define XB_XSUB(j)  (1280 + 64 * (j))
#define XB_XGEN(j)  (2304 + 64 * (j))
#define XB_TOP      3328
#define XB_TOPGEN   3392
#define XCD_BAR_WORDS 3456
#define XB_QUEUE(l) (3456 + 64 * (l))
#define BAR_WORDS_TOTAL 3712
#define XB_SPIN_CAP (1u << 23)
#define LAS __attribute__((address_space(3)))
DI unsigned xb_ld(unsigned* p) { return __hip_atomic_load(p, __ATOMIC_RELAXED, __HIP_MEMORY_SCOPE_AGENT); }
DI unsigned xb_add(unsigned* p, unsigned v) { return __hip_atomic_fetch_add(p, v, __ATOMIC_RELAXED, __HIP_MEMORY_SCOPE_AGENT); }
DI unsigned xb_xcc_id() { return (unsigned)__builtin_amdgcn_s_getreg((3 << 11) | 20) & 0xFu; }
#define XB_SPIN(cond, bar) do { unsigned _sp = 0; while (cond) { __builtin_amdgcn_s_sleep(1); \
    if ((++_sp & 255u) == 0u) { if (xb_ld(&(bar)[XB_TMO])) break; if (_sp > XB_SPIN_CAP) { atomicAdd(&(bar)[XB_TMO], 1u); break; } } } } while (0)
struct XcdBarrier { unsigned* bar; unsigned x; volatile LAS unsigned* st; };
DI XcdBarrier xcd_barrier_post(unsigned* bar, volatile LAS unsigned* st) {
  XcdBarrier b; b.bar = bar; b.x = xb_xcc_id(); b.st = st;
  if (threadIdx.x == 0) (void)xb_add(&bar[XB_XCNT(b.x)], 1u);
  return b;
}
DI void xcd_barrier_complete(unsigned* bar, unsigned x, unsigned& nloc, unsigned& nx) {
  const unsigned G = gridDim.x * gridDim.y * gridDim.z;
  unsigned sum, cnt, mine, sp = 0u;
  for (;;) {
    sum = 0u; cnt = 0u; mine = 0u;
#pragma unroll
    for (unsigned j = 0; j < 16; ++j) { const unsigned c = xb_ld(&bar[XB_XCNT(j)]); sum += c; cnt += (c > 0u) ? 1u : 0u; mine = (j == x) ? c : mine; }
    if (sum == G) break;
    __builtin_amdgcn_s_sleep(1);
    if ((++sp & 255u) == 0u) { if (xb_ld(&bar[XB_TMO])) break; if (sp > XB_SPIN_CAP) { atomicAdd(&bar[XB_TMO], 1u); break; } }
  }
  nloc = mine > 0u ? mine : 1u; nx = cnt > 0u ? cnt : 1u;
}
DI void xcd_barrier(const XcdBarrier& b) {
  asm volatile("s_waitcnt vmcnt(0)" ::: "memory");
  __syncthreads();
  if (threadIdx.x == 0) {
    unsigned* bar = b.bar;
    __builtin_amdgcn_s_waitcnt(0);
    unsigned nloc = b.st[0], nx = b.st[1];
    if (nloc == 0u) { xcd_barrier_complete(bar, b.x, nloc, nx); b.st[0] = nloc; b.st[1] = nx; }
    const unsigned old = xb_add(&bar[XB_XSUB(b.x)], 1u);
    const unsigned gen = old / nloc;
    if (old + 1u == (gen + 1u) * nloc) {
      __builtin_amdgcn_fence(__ATOMIC_RELEASE, "agent");
      asm volatile("s_waitcnt vmcnt(0)" ::: "memory");
      const unsigned og = xb_add(&bar[XB_TOP], 1u);
      const unsigned tg = og / nx;
      if (og + 1u == (tg + 1u) * nx) xb_add(&bar[XB_TOPGEN], 1u);
      else XB_SPIN(xb_ld(&bar[XB_TOPGEN]) == tg, bar);
      __builtin_amdgcn_fence(__ATOMIC_ACQUIRE, "agent");
      xb_add(&bar[XB_XGEN(b.x)], 1u);
      asm volatile("s_waitcnt vmcnt(0)" ::: "memory");
    } else {
      XB_SPIN(xb_ld(&bar[XB_XGEN(b.x)]) == gen, bar);
      __builtin_amdgcn_fence(__ATOMIC_ACQUIRE, "agent");
      asm volatile("s_waitcnt vmcnt(0)" ::: "memory");
    }
  }
  __syncthreads();
}

DI void transpose_tile(const float* __restrict__ W, int K, int N, bf16_t* __restrict__ WT, bf16_t* __restrict__ WT2, int kt, int nt, int mode, float* lds, bool valid) {
  const int tid = tidx() & 255;
  const int k0 = kt * 128, n0 = nt * 64;
  if (valid) {
    f32x4 t4[8];
    const int c = (tid & 15) * 4, n = n0 + c;
#pragma unroll
    for (int pp = 0; pp < 8; ++pp) {
      const int r = pp * 16 + (tid >> 4);
      t4[pp] = (n + 3 < N) ? __builtin_nontemporal_load((const f32x4*)(W + (size_t)(k0 + r) * N + n)) : (f32x4){0.f, 0.f, 0.f, 0.f};
    }
#pragma unroll
    for (int pp = 0; pp < 8; ++pp) {
      const int r = pp * 16 + (tid >> 4);
      lds[r * 65 + c + 0] = t4[pp][0]; lds[r * 65 + c + 1] = t4[pp][1]; lds[r * 65 + c + 2] = t4[pp][2]; lds[r * 65 + c + 3] = t4[pp][3];
    }
  }
  __syncthreads();
  if (valid) {
    int nl = tid >> 2, kq = tid & 3;
    int n = n0 + nl;
    bf16_t* dstbase = WT;
    int orow = n;
    if (mode == 1) orow = (n < DFF) ? ((n >> 7) * 256 + (n & 127)) : (((n - DFF) >> 7) * 256 + 128 + ((n - DFF) & 127));
    if (mode == 2) {
      if (n < 1024) { const int d = n & 63; orow = (n & ~63) + (d < 32 ? 2 * d : 2 * (d - 32) + 1); }
      else if (n < 1536) { orow = n - 1024; dstbase = WT2; }
      else orow = n - 512;
    }
    if (n < N) {
#pragma unroll
      for (int hk = 0; hk < 2; ++hk) {
        unsigned w[8];
#pragma unroll
        for (int i = 0; i < 8; ++i) w[i] = pack2(lds[(hk * 64 + kq * 16 + 2 * i) * 65 + nl], lds[(hk * 64 + kq * 16 + 2 * i + 1) * 65 + nl]);
        u32x4* dst = (u32x4*)(dstbase + (size_t)orow * K + k0 + hk * 64 + kq * 16);
        dst[0] = mk4(w[0], w[1], w[2], w[3]);
        dst[1] = mk4(w[4], w[5], w[6], w[7]);
      }
    }
  }
  __syncthreads();
}

constexpr int WT_IN = 8 * 61, WT_OUT = 8 * 16, WT_UP = 8 * 88, WT_DOWN = 22 * 16;
constexpr int WT_ITEMS = WT_IN + WT_OUT + WT_UP + WT_DOWN;
constexpr int WPRE = 112 * 4;
DI void weight_item(const Params& p, int layer, int it, float* lds, bool valid) {
  if (it < WT_IN) { transpose_tile(p.w_in + (size_t)layer * D * INC, D, INC, p.WinT, p.WvT, it % 8, it / 8, 2, lds, valid); return; }
  it -= WT_IN;
  if (it < WT_OUT) { transpose_tile(p.w_out + (size_t)layer * D * D, D, D, p.WoutT, nullptr, it % 8, it / 8, 0, lds, valid); return; }
  it -= WT_OUT;
  if (it < WT_UP) { transpose_tile(p.ffn_w_up + (size_t)layer * D * 2 * DFF, D, 2 * DFF, p.WupT, nullptr, it % 8, it / 8, 1, lds, valid); return; }
  it -= WT_UP;
  transpose_tile(p.ffn_w_down + (size_t)layer * DFF * D, DFF, D, p.WdownT, nullptr, it % 22, it / 22, 0, lds, valid);
}
DI void weight_pair(const Params& p, int layer, int first, int last, int pair, char* smem) {
  const int half = tidx() >> 8;
  float* lds = (float*)smem + half * 8448;
  const int it = first + pair * 2 + half;
  const bool valid = it < last;
  weight_item(p, layer, valid ? it : last - 1, lds, valid);
}

DI void mod_item(const Params& p, int it2, float* lds) {
  const int tid = tidx() & 255, half = tidx() >> 8;
  const int it = it2 * 2 + half;
  const int layer = it / 192, n0 = (it % 192) * 32;
  float* sc = lds;
  float* red = lds + 9 * 1024 + half * 9216;
  for (int i = tidx(); i < 9 * 1024; i += NTHR) {
    float v = (i < 8 * 1024) ? p.c[i] : p.c_ctx[i - 8 * 1024];
    sc[i] = silu_f(v);
  }
  __syncthreads();
  const int kg = tid >> 3, c4 = (tid & 7) * 4;
  f32x4 acc[9];
#pragma unroll
  for (int i = 0; i < 9; ++i) acc[i] = (f32x4){0.f, 0.f, 0.f, 0.f};
  const float* w = p.ada_w + (size_t)layer * D * 6144 + n0 + c4;
#pragma unroll 4
  for (int kb = 0; kb < 32; kb += 8) {
    f32x4 wv[8];
#pragma unroll
    for (int u = 0; u < 8; ++u) wv[u] = __builtin_nontemporal_load((const f32x4*)(w + (size_t)(kg * 32 + kb + u) * 6144));
#pragma unroll
    for (int u = 0; u < 8; ++u)
#pragma unroll
      for (int i = 0; i < 9; ++i) acc[i] += wv[u] * sc[i * 1024 + kg * 32 + kb + u];
  }
#pragma unroll
  for (int i = 0; i < 9; ++i) *(f32x4*)(red + (kg * 9 + i) * 32 + c4) = acc[i];
  __syncthreads();
  for (int t = tid; t < 288; t += 256) {
    int i = t >> 5, cc = t & 31;
    float sacc = p.ada_b[layer * 6144 + n0 + cc];
#pragma unroll 8
    for (int g = 0; g < 32; ++g) sacc += red[(g * 9 + i) * 32 + cc];
    p.mod[(size_t)(layer * 9 + i) * 6144 + n0 + cc] = sacc;
  }
  __syncthreads();
}

DI void rope_item(const Params& p, int it) {
  for (int i = 0; i < 2; ++i) {
    int idx = it * 1024 + i * 512 + tidx();
    int t = idx >> 5, j = idx & 31;
    float pos = (float)((j < 16) ? (t >> 6) : (t & 63));
    float inv = exp2f(-(float)(j & 15) * (13.287712379549449f / 16.f));
    float ang = pos * inv;
    double rev = (double)ang * 0.15915494309189535;
    rev -= floor(rev);
    float fr = (float)rev;
    p.ropec[idx] = __builtin_amdgcn_cosf(fr);
    p.ropes[idx] = __builtin_amdgcn_sinf(fr);
  }
}

DI float wave_sum(float v) {
#pragma unroll
  for (int o = 32; o >= 1; o >>= 1) v += __shfl_xor(v, o);
  return v;
}
DI void update_phase(const Params& p, int layer, int which, int mode, int bofs, int nb) {
  const int lane = tidx() & 63, wid = tidx() >> 6;
  const int nrows = (layer == 1) ? NLAT : NROW;
  const bool last = (layer == 1 && which == 2);
  const int gw = (bidx() - bofs) * NWAVE + wid, nw = nb * NWAVE;
  const int nl = (which == 2) ? layer + 1 : layer;
  const int gi = (which == 1) ? 2 : 0, sh = (which == 1) ? 3 : 0;
  const bool from_in = (layer == 0 && which <= 1);
  float4 pg[4], pgt[4], ng[4], nsf[4], nsc[4];
  auto load_params = [&](int mi) {
    const float* modp = p.mod + (size_t)(layer * 9 + mi) * 6144;
    const float* gate = modp + (which == 1 ? 2 : 5) * 1024;
    const float* gp = p.norm_g + (size_t)(layer * 4 + (which == 1 ? 1 : 3)) * 1024;
    const float* modn = p.mod + (size_t)(nl * 9 + mi) * 6144;
    const float* gn = p.norm_g + (size_t)(nl * 4 + gi) * 1024;
#pragma unroll
    for (int i = 0; i < 4; ++i) {
      if (which != 0) { pg[i] = *(const float4*)(gp + i * 256 + lane * 4); pgt[i] = *(const float4*)(gate + i * 256 + lane * 4); }
      if (!last) {
        ng[i] = *(const float4*)(gn + i * 256 + lane * 4);
        nsf[i] = *(const float4*)(modn + sh * 1024 + i * 256 + lane * 4);
        nsc[i] = *(const float4*)(modn + (sh + 1) * 1024 + i * 256 + lane * 4);
      }
    }
  };
  auto row_src = [&](int r) -> const float* {
    if (r < NLAT) return from_in ? p.x + (size_t)r * D : p.out + (size_t)r * D;
    return from_in ? p.ctx + (size_t)(r - NLAT) * D : p.cx + (size_t)(r - NLAT) * D;
  };
  auto load_row = [&](int r, float4 (&xv)[4], u32x2 (&um)[4]) {
    const float* xs = row_src(r);
#pragma unroll
    for (int i = 0; i < 4; ++i) { const f32x4 t4 = __builtin_nontemporal_load((const f32x4*)(xs + i * 256 + lane * 4)); xv[i] = make_float4(t4[0], t4[1], t4[2], t4[3]); }
    if (which != 0) {
      const bf16_t* mr = p.mix + (size_t)r * D;
#pragma unroll
      for (int i = 0; i < 4; ++i) um[i] = __builtin_nontemporal_load((const u32x2*)(mr + i * 256 + lane * 4));
    }
  };
  auto do_row = [&](int r, float4 (&xv)[4], const u32x2 (&um)[4]) {
    float* xd = (r < NLAT) ? p.out + (size_t)r * D : p.cx + (size_t)(r - NLAT) * D;
    if (which != 0) {
      float4 mv[4];
      float ss = 0.f;
#pragma unroll
      for (int i = 0; i < 4; ++i) {
        mv[i] = make_float4(__uint_as_float(um[i].x << 16), __uint_as_float(um[i].x & 0xffff0000u), __uint_as_float(um[i].y << 16), __uint_as_float(um[i].y & 0xffff0000u));
        ss += mv[i].x * mv[i].x + mv[i].y * mv[i].y + mv[i].z * mv[i].z + mv[i].w * mv[i].w;
      }
      ss = wave_sum(ss);
      const float rstd = rsqrtf(ss * (1.f / 1024.f) + 1e-6f);
#pragma unroll
      for (int i = 0; i < 4; ++i) {
        xv[i].x += pgt[i].x * (mv[i].x * rstd * pg[i].x);
        xv[i].y += pgt[i].y * (mv[i].y * rstd * pg[i].y);
        xv[i].z += pgt[i].z * (mv[i].z * rstd * pg[i].z);
        xv[i].w += pgt[i].w * (mv[i].w * rstd * pg[i].w);
        { const f32x4 t4 = {xv[i].x, xv[i].y, xv[i].z, xv[i].w}; __builtin_nontemporal_store(t4, (f32x4*)(xd + i * 256 + lane * 4)); }
      }
    }
    if (!last) {
      float ss = 0.f;
#pragma unroll
      for (int i = 0; i < 4; ++i) ss += xv[i].x * xv[i].x + xv[i].y * xv[i].y + xv[i].z * xv[i].z + xv[i].w * xv[i].w;
      ss = wave_sum(ss);
      const float rstd = rsqrtf(ss * (1.f / 1024.f) + 1e-6f);
      bf16_t* dst = p.Abuf + (size_t)r * D;
#pragma unroll
      for (int i = 0; i < 4; ++i) {
        float a = (xv[i].x * rstd * ng[i].x) * (1.f + nsc[i].x) + nsf[i].x;
        float b = (xv[i].y * rstd * ng[i].y) * (1.f + nsc[i].y) + nsf[i].y;
        float c = (xv[i].z * rstd * ng[i].z) * (1.f + nsc[i].z) + nsf[i].z;
        float d = (xv[i].w * rstd * ng[i].w) * (1.f + nsc[i].w) + nsf[i].w;
        *(u32x2*)(dst + i * 256 + lane * 4) = mk2(pack2(a, b), pack2(c, d));
      }
    }
  };
  if (mode == 2) {
    float4 xa[4];
    u32x2 ma[4];
    load_params(8);
    for (int rc = NLAT + gw; rc < NROW; rc += nw) { load_row(rc, xa, ma); do_row(rc, xa, ma); }
  } else if ((nw & 7) == 0 && nw <= 8 * SEQ) {
    const int wpb = nw >> 3, bb = gw / wpb, wl = gw % wpb;
    load_params(bb);
    float4 xa[4], xb[4];
    u32x2 ma[4], mb[4];
    int r = bb * SEQ + wl;
    const int rend = (bb + 1) * SEQ;
    if (r < rend) load_row(r, xa, ma);
    while (r < rend) {
      const int r2 = r + wpb;
      if (r2 < rend) load_row(r2, xb, mb);
      do_row(r, xa, ma);
      if (r2 >= rend) break;
      const int r3 = r2 + wpb;
      if (r3 < rend) load_row(r3, xa, ma);
      do_row(r2, xb, mb);
      r = r3;
    }
    if (mode == 0 && nrows > NLAT) {
      load_params(8);
      for (int rc = NLAT + gw; rc < NROW; rc += nw) { load_row(rc, xa, ma); do_row(rc, xa, ma); }
    }
  } else {
    float4 xa[4];
    u32x2 ma[4];
    for (int r = gw; r < (mode == 1 ? NLAT : nrows); r += nw) { load_params((r < NLAT) ? (r >> 11) : 8); load_row(r, xa, ma); do_row(r, xa, ma); }
  }
}

constexpr int EPI_P = 0, EPI_MIX = 1, EPI_CONV = 2, EPI_VT = 3;
constexpr int G_BM = 256, G_BK = 64, G_HALF = 128, G_HTB = G_HALF * G_BK * 2, G_STAGE_BYTES = 8 * G_HTB, G_NXCD = 8, G_WGM = 8;
constexpr int HB_LAT = 34, HB_CTX = 5, HB_NLAT = NB * HB_LAT, HB_NCTX = NB * HB_CTX;
DI int g_lds_byte(int r, int c) { const int st = (r >> 4) * 2 + (c >> 5), rr = r & 15, cc = c & 31, ob = rr * 64 + cc * 2; return st * 1024 + (ob ^ (((ob >> 9) & 1) << 5)); }
DI void g_stage_rc(int b, int& R, int& C) { const int st = b / 1024, sb = b % 1024, swz = sb ^ (((sb >> 9) & 1) << 5); R = (st >> 1) * 16 + swz / 64; C = (st & 1) * 32 + (swz % 64) / 2; }
DI int g_perm32(int rho) { const int n = rho >> 4, i = rho & 15; return 8 * (i >> 2) + 4 * n + (i & 3); }
struct GUnit { int pm, pn; };
struct GOrder {
  int nM, nN, nwg, G, c;
  DI void init(int nM_, int nN_, int G_, int c_) { nM = nM_; nN = nN_; nwg = nM * nN; G = G_; c = c_; }
  DI bool next(int i, GUnit& u) const {
    const long L = (long)i * G + c; if (L >= nwg) return false;
    int wgid = (int)L; { const int q = nwg / G_NXCD, r = nwg % G_NXCD, xcd = wgid % G_NXCD, off = wgid / G_NXCD; wgid = (xcd < r ? xcd * (q + 1) : r * (q + 1) + (xcd - r) * q) + off; }
    const int nig = G_WGM * nN, gid = wgid / nig, fm = gid * G_WGM, gsz = (nM - fm) < G_WGM ? (nM - fm) : G_WGM;
    u.pm = fm + ((wgid % nig) % gsz); u.pn = (wgid % nig) / gsz; return true;
  }
};
DI void halo_block(int blk, int& base, int& L, int& t0) {
  if (blk < HB_NLAT) { const int s = blk / HB_LAT, i = blk % HB_LAT; base = s * SEQ; L = SEQ; t0 = 62 * i - 1; }
  else { const int b2 = blk - HB_NLAT; const int s = b2 / HB_CTX, i = b2 % HB_CTX; base = NLAT + s * CTXL; L = CTXL; t0 = 62 * i - 1; }
}
template <int AMODE>
DI void g_a_offsets(int pm, int K, const int (&R)[2], const int (&C)[2], unsigned (&o)[2][2]) {
#pragma unroll
  for (int h = 0; h < 2; ++h)
#pragma unroll
    for (int i = 0; i < 2; ++i) {
      const int tr = h * 128 + R[i];
      int grow;
      if (AMODE == 0) grow = pm * 256 + tr;
      else {
        int base, L, t0; halo_block(pm * 4 + (tr >> 6), base, L, t0);
        const int t = t0 + (tr & 63);
        grow = (t >= 0 && t < L) ? base + t : NROW;
      }
      o[h][i] = (unsigned)(grow * K + C[i]) * 2u;
    }
}

template <int EPI> DI void g_epilogue(const Params& p, int layer, const f32x4 (&acc)[2][2][4][2], const GUnit& u, int wr, int wc, int fr, int fq);

template <int EPI, int AMODE>
DI void gemm_phase(const Params& p, int layer, LAS unsigned char* lds, const bf16_t* A, const bf16_t* Bt, int K, int nM, int nN, int pm_base = 0, int Gov = 0, int cov = 0) {
  const int tid = tidx(), wid = __builtin_amdgcn_readfirstlane(tid >> 6), lane = tid & 63, wr = wid >> 2, wc = wid & 3, fr = lane & 15, fq = lane >> 4;
  const int nt = K / G_BK;
  int sR[2], sC[2];
  unsigned voffB[2];
#pragma unroll
  for (int i = 0; i < 2; ++i) { g_stage_rc(tid * 16 + i * 8192, sR[i], sC[i]); const int Rb = (sR[i] & ~31) + g_perm32(sR[i] & 31); voffB[i] = (unsigned)(Rb * K + sC[i]) * 2u; }
  const size_t kstep = (size_t)(G_BK * 2);
  const size_t hstep = (size_t)G_HALF * K * 2;
  const size_t tstep = 2 * hstep;
  const unsigned ldsw = (unsigned)wid * 1024u;
  const int aoff = g_lds_byte(wr * 64 + fr, fq * 8), boff = g_lds_byte(wc * 32 + fr, fq * 8);
  const char* gA = (const char*)A;
#define PG8_SA(b, h) (((b) * 2 + (h)) * G_HTB)
#define PG8_SB(b, h) ((4 + (b) * 2 + (h)) * G_HTB)
#define PG8_STAGE(bufoff, gbase, voff) do { _Pragma("unroll") for (int _i = 0; _i < 2; ++_i) \
    __builtin_amdgcn_global_load_lds((const unsigned*)((const char*)(gbase) + (voff)[_i]), (LAS unsigned*)(lds + (bufoff) + ldsw + _i * 8192), 16, 0, 0); } while (0)
#define PG8_LDA(dst, b, h) do { _Pragma("unroll") for (int m = 0; m < 4; ++m) _Pragma("unroll") for (int k = 0; k < 2; ++k) dst[m][k] = *(const LAS bf16x8*)(lds + PG8_SA(b, h) + aoff + m * 2048 + k * 1024); } while (0)
#define PG8_LDB(dst, b, h) do { _Pragma("unroll") for (int n = 0; n < 2; ++n) _Pragma("unroll") for (int k = 0; k < 2; ++k) dst[n][k] = *(const LAS bf16x8*)(lds + PG8_SB(b, h) + boff + n * 2048 + k * 1024); } while (0)
#define PG8_MMA(ai, bj, At, Bt_) do { __builtin_amdgcn_s_setprio(1); _Pragma("unroll") for (int m = 0; m < 4; ++m) _Pragma("unroll") for (int n = 0; n < 2; ++n) _Pragma("unroll") for (int k = 0; k < 2; ++k) \
    acc[ai][bj][m][n] = __builtin_amdgcn_mfma_f32_16x16x32_bf16(Bt_[n][k], At[m][k], acc[ai][bj][m][n], 0, 0, 0); __builtin_amdgcn_s_setprio(0); } while (0)
#define PG8_WAIT_V(n) asm volatile("s_waitcnt vmcnt(" #n ")" ::: "memory")
#define PG8_WAIT_L(n) asm volatile("s_waitcnt lgkmcnt(" #n ")" ::: "memory")
#define PG8_BAR __builtin_amdgcn_s_barrier()
#define PG8_SCHED __builtin_amdgcn_sched_barrier(0)
  GOrder S; S.init(nM, nN, Gov ? Gov : (int)gridDim.x, Gov ? cov : bidx());
  GUnit cur, nxt; int ui = 0;
  if (!S.next(0, cur)) return;
  cur.pm += pm_base;
  f32x4 acc[2][2][4][2];
#pragma unroll
  for (int a = 0; a < 2; ++a)
#pragma unroll
    for (int b = 0; b < 2; ++b)
#pragma unroll
      for (int m = 0; m < 4; ++m)
#pragma unroll
        for (int n = 0; n < 2; ++n) acc[a][b][m][n] = (f32x4){0.f, 0.f, 0.f, 0.f};
  bf16x8 At[4][2], B0[2][2], B1[2][2];
  unsigned curA[2][2];
  g_a_offsets<AMODE>(cur.pm, K, sR, sC, curA);
  const char* cB = (const char*)Bt + (size_t)cur.pn * tstep;
  PG8_STAGE(PG8_SB(0, 0), cB, voffB); PG8_STAGE(PG8_SA(0, 0), gA, curA[0]); PG8_STAGE(PG8_SB(0, 1), cB + hstep, voffB); PG8_STAGE(PG8_SA(0, 1), gA, curA[1]);
  if (wr == 1) PG8_BAR;
  PG8_WAIT_V(4); PG8_BAR;
  PG8_STAGE(PG8_SB(1, 0), cB + kstep, voffB); PG8_STAGE(PG8_SA(1, 0), gA + kstep, curA[0]); PG8_STAGE(PG8_SB(1, 1), cB + hstep + kstep, voffB);
  PG8_WAIT_V(6); PG8_BAR;
  for (;;) {
    {
      const int tid2 = tidx();
#pragma unroll
      for (int i = 0; i < 2; ++i) { g_stage_rc(tid2 * 16 + i * 8192, sR[i], sC[i]); const int Rb = (sR[i] & ~31) + g_perm32(sR[i] & 31); voffB[i] = (unsigned)(Rb * K + sC[i]) * 2u; }
      g_a_offsets<AMODE>(cur.pm, K, sR, sC, curA);
    }
    const bool has_next = S.next(ui + 1, nxt);
    if (has_next) nxt.pm += pm_base;
    const int npm = has_next ? nxt.pm : cur.pm;
    const char* nB = has_next ? (const char*)Bt + (size_t)nxt.pn * tstep : cB;
    for (int t = 0; t < nt; t += 2) {
      const bool last = (t == nt - 2);
      const char* a1 = gA + (size_t)(t + 1) * kstep;
      const char* a2 = last ? gA : gA + (size_t)(t + 2) * kstep;
      const char* b2 = last ? nB : cB + (size_t)(t + 2) * kstep;
      const char* a3 = a2 + kstep; const char* b3 = b2 + kstep;
      unsigned a2o[2][2];
      if (last) g_a_offsets<AMODE>(npm, K, sR, sC, a2o);
      else {
#pragma unroll
        for (int h = 0; h < 2; ++h)
#pragma unroll
          for (int i = 0; i < 2; ++i) a2o[h][i] = curA[h][i];
      }
      PG8_LDB(B0, 0, 0); PG8_SCHED; PG8_LDA(At, 0, 0); PG8_STAGE(PG8_SA(1, 1), a1, curA[1]);
      PG8_WAIT_L(8); PG8_BAR; PG8_WAIT_L(0); PG8_MMA(0, 0, At, B0); PG8_BAR; PG8_SCHED;
      PG8_LDB(B1, 0, 1); PG8_STAGE(PG8_SB(0, 0), b2, voffB);
      PG8_BAR; PG8_WAIT_L(0); PG8_MMA(0, 1, At, B1); PG8_BAR;
      PG8_LDA(At, 0, 1); PG8_STAGE(PG8_SA(0, 0), a2, a2o[0]);
      PG8_BAR; PG8_WAIT_L(0); PG8_MMA(1, 0, At, B0); PG8_BAR; PG8_SCHED;
      PG8_STAGE(PG8_SB(0, 1), b2 + hstep, voffB);
      PG8_WAIT_V(6); PG8_BAR; PG8_MMA(1, 1, At, B1); PG8_BAR;
      PG8_LDB(B0, 1, 0); PG8_SCHED; PG8_LDA(At, 1, 0); PG8_STAGE(PG8_SA(0, 1), a2, a2o[1]);
      PG8_WAIT_L(8); PG8_BAR; PG8_WAIT_L(0); PG8_MMA(0, 0, At, B0); PG8_BAR; PG8_SCHED;
      PG8_LDB(B1, 1, 1); PG8_STAGE(PG8_SB(1, 0), b3, voffB);
      PG8_BAR; PG8_WAIT_L(0); PG8_MMA(0, 1, At, B1); PG8_BAR;
      PG8_LDA(At, 1, 1); PG8_STAGE(PG8_SA(1, 0), a3, a2o[0]);
      PG8_BAR; PG8_WAIT_L(0); PG8_MMA(1, 0, At, B0); PG8_BAR; PG8_SCHED;
      PG8_STAGE(PG8_SB(1, 1), b3 + hstep, voffB);
      PG8_WAIT_V(6); PG8_BAR; PG8_MMA(1, 1, At, B1); PG8_BAR;
    }
    g_epilogue<EPI>(p, layer, acc, cur, wr, wc, fr, fq);
    if (!has_next) break;
#pragma unroll
    for (int a = 0; a < 2; ++a)
#pragma unroll
      for (int b = 0; b < 2; ++b)
#pragma unroll
        for (int m = 0; m < 4; ++m)
#pragma unroll
          for (int n = 0; n < 2; ++n) acc[a][b][m][n] = (f32x4){0.f, 0.f, 0.f, 0.f};
    cur = nxt; cB = nB; ++ui;
  }
  PG8_WAIT_V(0);
  if (wr == 0) PG8_BAR;
  PG8_BAR;
#undef PG8_SA
#undef PG8_SB
#undef PG8_STAGE
#undef PG8_LDA
#undef PG8_LDB
#undef PG8_MMA
#undef PG8_WAIT_V
#undef PG8_WAIT_L
#undef PG8_BAR
#undef PG8_SCHED
}

DI float dpp_ror1(float v) { return __int_as_float(__builtin_amdgcn_update_dpp(0, __float_as_int(v), 0x121, 0xF, 0xF, true)); }
DI float dpp_ror15(float v) { return __int_as_float(__builtin_amdgcn_update_dpp(0, __float_as_int(v), 0x12F, 0xF, 0xF, true)); }
template <int EPI>
DI void g_epilogue(const Params& p, int layer, const f32x4 (&acc)[2][2][4][2], const GUnit& u, int wr, int wc, int fr, int fq) {
  if (EPI == EPI_MIX) {
#pragma unroll
    for (int ai = 0; ai < 2; ++ai)
#pragma unroll
      for (int m = 0; m < 4; ++m) {
        bf16_t* rowp = p.mix + (size_t)(u.pm * 256 + ai * 128 + wr * 64 + m * 16 + fr) * D + u.pn * 256 + wc * 32 + 8 * fq;
#pragma unroll
        for (int bj = 0; bj < 2; ++bj) {
          const f32x4 v0 = acc[ai][bj][m][0], v1 = acc[ai][bj][m][1];
          *(u32x4*)(rowp + bj * 128) = mk4(pack2(v0[0], v0[1]), pack2(v0[2], v0[3]), pack2(v1[0], v1[1]), pack2(v1[2], v1[3]));
        }
      }
  } else if (EPI == EPI_P) {
    const bool is_lat = (u.pm * 256) < NLAT;
    const bool qk = u.pn < 4;
    const float qs = (u.pn < 2) ? (0.125f * 1.4426950408889634f) : 1.f;
#pragma unroll
    for (int ai = 0; ai < 2; ++ai)
#pragma unroll
      for (int m = 0; m < 4; ++m) {
        const int row = u.pm * 256 + ai * 128 + wr * 64 + m * 16 + fr;
        bf16_t* rowp = p.P + (size_t)row * PW + u.pn * 256 + wc * 32 + 8 * fq;
        f32x4 cs = {1.f, 1.f, 1.f, 1.f}, sn = {0.f, 0.f, 0.f, 0.f};
        if (qk && is_lat) {
          const int t = row & (SEQ - 1), d0 = (wc & 1) * 16 + 4 * fq;
          cs = *(const f32x4*)(p.ropec + t * 32 + d0);
          sn = *(const f32x4*)(p.ropes + t * 32 + d0);
        }
#pragma unroll
        for (int bj = 0; bj < 2; ++bj) {
          f32x4 v0 = acc[ai][bj][m][0], v1 = acc[ai][bj][m][1];
          if (qk) {
            const f32x4 w0 = {v0[0] * cs[0] - v0[1] * sn[0], v0[1] * cs[0] + v0[0] * sn[0], v0[2] * cs[1] - v0[3] * sn[1], v0[3] * cs[1] + v0[2] * sn[1]};
            const f32x4 w1 = {v1[0] * cs[2] - v1[1] * sn[2], v1[1] * cs[2] + v1[0] * sn[2], v1[2] * cs[3] - v1[3] * sn[3], v1[3] * cs[3] + v1[2] * sn[3]};
            v0 = w0 * qs; v1 = w1 * qs;
          }
          const int col = u.pn * 256 + bj * 128 + wc * 32 + 8 * fq;
          if (col < PW) *(u32x4*)(rowp + bj * 128) = mk4(pack2(v0[0], v0[1]), pack2(v0[2], v0[3]), pack2(v1[0], v1[1]), pack2(v1[2], v1[3]));
        }
      }
  } else if (EPI == EPI_VT) {
#pragma unroll
    for (int ai = 0; ai < 2; ++ai)
#pragma unroll
      for (int m = 0; m < 4; ++m) {
        const int hh = u.pm * 2 + ai, dv = wr * 64 + m * 16 + fr;
#pragma unroll
        for (int bj = 0; bj < 2; ++bj) {
          const int tok = u.pn * 256 + bj * 128 + wc * 32 + 8 * fq;
          int bb, key;
          if (tok < NLAT) { bb = tok >> 11; key = CTXL + (tok & (SEQ - 1)); } else { bb = (tok - NLAT) >> 8; key = (tok - NLAT) & (CTXL - 1); }
          const f32x4 v0 = acc[ai][bj][m][0], v1 = acc[ai][bj][m][1];
          *(u32x4*)(p.Vt + ((size_t)((bb * 4 + hh) * 128 + dv)) * NKEY + key) = mk4(pack2(v0[0], v0[1]), pack2(v0[2], v0[3]), pack2(v1[0], v1[1]), pack2(v1[2], v1[3]));
        }
      }
  } else {
    const int f0 = u.pn * 128 + wc * 32 + 8 * fq;
    const float* cw = p.ffn_conv_w + (size_t)layer * 3 * 2 * DFF + f0;
    const float* cbp = p.ffn_conv_b + (size_t)layer * 2 * DFF + f0;
#pragma unroll
    for (int q = 0; q < 2; ++q) {
      f32x4 wg[3], wv[3], bg, bv;
#pragma unroll
      for (int j = 0; j < 3; ++j) { wg[j] = *(const f32x4*)(cw + j * 2 * DFF + 4 * q); wv[j] = *(const f32x4*)(cw + j * 2 * DFF + DFF + 4 * q); }
      bg = *(const f32x4*)(cbp + 4 * q); bv = *(const f32x4*)(cbp + DFF + 4 * q);
#pragma unroll
      for (int ai = 0; ai < 2; ++ai) {
        int base, L, t0; halo_block(u.pm * 4 + ai * 2 + wr, base, L, t0);
#pragma unroll
        for (int m = 0; m < 4; ++m) {
          const int r = m * 16 + fr, t = t0 + r;
          const int mp = m > 0 ? m - 1 : 0, mn = m < 3 ? m + 1 : 3;
          f32x4 o;
#pragma unroll
          for (int j = 0; j < 4; ++j) {
            const float gc = acc[ai][0][m][q][j], vc = acc[ai][1][m][q][j];
            const float gp = dpp_ror1(fr == 15 ? acc[ai][0][mp][q][j] : gc), gn = dpp_ror15(fr == 0 ? acc[ai][0][mn][q][j] : gc);
            const float vp = dpp_ror1(fr == 15 ? acc[ai][1][mp][q][j] : vc), vn = dpp_ror15(fr == 0 ? acc[ai][1][mn][q][j] : vc);
            const float gg = wg[0][j] * gp + wg[1][j] * gc + wg[2][j] * gn + bg[j];
            const float vv = wv[0][j] * vp + wv[1][j] * vc + wv[2][j] * vn + bv[j];
            o[j] = gg * __builtin_amdgcn_rcpf(1.f + __expf(-gg)) * vv;
          }
          if (r >= 1 && r <= 62 && t < L)
            *(u32x2*)((char*)p.act + (unsigned)(((base + t) * DFF + f0 + 4 * q) * 2)) = mk2(pack2(o[0], o[1]), pack2(o[2], o[3]));
          __builtin_amdgcn_sched_barrier(0);
        }
      }
      __builtin_amdgcn_sched_barrier(0);
    }
  }
}

DI void attn_item(const Params& p, int layer, int item, char* smem) {
  constexpr int LDK = 136, LDV = 72;
  bf16_t* sK = (bf16_t*)smem;
  bf16_t* sV = sK + 64 * LDK;
  const int tid = tidx(), lane = tid & 63, wid = tid >> 6, l15 = lane & 15, quad = lane >> 4;
  bool isctx; int b, h, qb;
  if (item < 512) { b = item >> 6; h = (item >> 4) & 3; qb = item & 15; isctx = false; }
  else { int it = item - 512; b = it >> 3; h = (it >> 1) & 3; qb = it & 1; isctx = true; }
  const float lam_init = 0.8f - 0.6f * expf(-0.3f * (float)layer);
  float lam;
  {
    const float* lp = p.da_lambda + layer * 256;
    float a = lp[lane] * lp[64 + lane], c2 = lp[128 + lane] * lp[192 + lane];
    a = wave_sum(a); c2 = wave_sum(c2);
    lam = expf(a) - expf(c2) + lam_init;
  }
  const int qrow = (isctx ? NLAT + b * CTXL : b * SEQ) + qb * 128 + wid * 16 + l15;
  bf16x8 qf[2][2];
#pragma unroll
  for (int m = 0; m < 2; ++m)
#pragma unroll
    for (int kk = 0; kk < 2; ++kk) qf[m][kk] = *(const bf16x8*)(p.P + (size_t)qrow * PW + PC_Q + h * 128 + m * 64 + kk * 32 + quad * 8);
  const int ntile = isctx ? 4 : 36;
  const int k0_ = tid >> 4, kch = tid & 15;
  const int kpi0 = ((k0_ >> 2) & 1) * 16 + ((k0_ >> 3) & 3) * 4 + (k0_ & 3);
  const int kldsoff0 = kpi0 * LDK + kch * 8;
#define KLDS(i) (kldsoff0 + (i) * 32 * LDK)
  const long kgoff0 = (long)k0_ * PW + PC_K + h * 128 + kch * 8;
  const long kgstep = (long)32 * PW;
  const int dv0_ = tid >> 3, c8_ = tid & 7;
  const int vldsoff0 = dv0_ * LDV + c8_ * 8;
  const long vgoff0 = ((long)((b * 4 + h) * 128 + dv0_)) * NKEY + c8_ * 8;
  const long vgstep = (long)64 * NKEY;
  f32x4 oacc[2][8];
#pragma unroll
  for (int m = 0; m < 2; ++m)
#pragma unroll
    for (int t = 0; t < 8; ++t) oacc[m][t] = (f32x4){0.f, 0.f, 0.f, 0.f};
  float mrun0 = -1e30f, mrun1 = -1e30f, lsum0 = 0.f, lsum1 = 0.f;
  u32x4 rk[2], rv[2];
  {
    const bf16_t* kbase = p.P + (size_t)(NLAT + b * CTXL) * PW;
#pragma unroll
    for (int i = 0; i < 2; ++i) { rk[i] = *(const u32x4*)(kbase + kgoff0 + i * kgstep); rv[i] = *(const u32x4*)(p.Vt + vgoff0 + i * vgstep); }
  }
  constexpr int KBUF = 64 * LDK, VBUF = 128 * LDV;
  bf16_t* const sK0 = sK;
  bf16_t* const sV0 = sK + 2 * KBUF;
  const bool late = wid >= 4;
  bf16x8 pf[2][2];
#pragma unroll
  for (int m = 0; m < 2; ++m)
#pragma unroll
    for (int s_ = 0; s_ < 2; ++s_) pf[m][s_] = (bf16x8){0, 0, 0, 0, 0, 0, 0, 0};
  auto pv = [&](const bf16_t* sVx) {
#pragma unroll
    for (int s_ = 0; s_ < 2; ++s_)
#pragma unroll
      for (int t = 0; t < 8; ++t) {
        if ((t & 3) == 0) __builtin_amdgcn_sched_barrier(0);
        bf16x8 a = *(const bf16x8*)(sVx + (t * 16 + l15) * LDV + s_ * 32 + quad * 8);
        oacc[0][t] = __builtin_amdgcn_mfma_f32_16x16x32_bf16(a, pf[0][s_], oacc[0][t], 0, 0, 0);
        oacc[1][t] = __builtin_amdgcn_mfma_f32_16x16x32_bf16(a, pf[1][s_], oacc[1][t], 0, 0, 0);
      }
  };
  __syncthreads();
#pragma unroll
  for (int i = 0; i < 2; ++i) { *(u32x4*)(sK0 + KLDS(i)) = rk[i]; *(u32x4*)(sV0 + vldsoff0 + i * 64 * LDV) = rv[i]; }
  __syncthreads();
  for (int kt = 0; kt < ntile; ++kt) {
    sK = sK0 + (kt & 1) * KBUF;
    sV = sV0 + (kt % 3) * VBUF;
    if (kt + 1 < ntile) {
      int k2 = kt + 1;
      const bf16_t* kbase = (k2 < 4) ? p.P + (size_t)(NLAT + b * CTXL + k2 * 64) * PW : p.P + (size_t)(b * SEQ + (k2 - 4) * 64) * PW;
#pragma unroll
      for (int i = 0; i < 2; ++i) { rk[i] = *(const u32x4*)(kbase + kgoff0 + i * kgstep); rv[i] = *(const u32x4*)(p.Vt + vgoff0 + i * vgstep + k2 * 64); }
    }
    if (late && kt > 0) pv(sV0 + ((kt + 2) % 3) * VBUF);
    f32x4 sacc[2][4];
    __builtin_amdgcn_sched_barrier(0);
#pragma unroll
    for (int m = 0; m < 2; ++m)
#pragma unroll
      for (int tau = 0; tau < 4; ++tau) {
        f32x4 s = (f32x4){0.f, 0.f, 0.f, 0.f};
#pragma unroll
        for (int kk = 0; kk < 2; ++kk) {
          bf16x8 a = *(const bf16x8*)(sK + (tau * 16 + l15) * LDK + m * 64 + kk * 32 + quad * 8);
          s = __builtin_amdgcn_mfma_f32_16x16x32_bf16(a, qf[m][kk], s, 0, 0, 0);
        }
        sacc[m][tau] = s;
      }
    __builtin_amdgcn_sched_barrier(0);
#pragma unroll
    for (int m = 0; m < 2; ++m) {
      float mx = sacc[m][0][0];
#pragma unroll
      for (int tau = 0; tau < 4; ++tau)
#pragma unroll
        for (int j = 0; j < 4; ++j) mx = fmaxf(mx, sacc[m][tau][j]);
      {
        const auto r16 = __builtin_amdgcn_permlane16_swap(__float_as_uint(mx), __float_as_uint(mx), false, false);
        mx = fmaxf(__uint_as_float(r16[0]), __uint_as_float(r16[1]));
        const auto r32 = __builtin_amdgcn_permlane32_swap(__float_as_uint(mx), __float_as_uint(mx), false, false);
        mx = fmaxf(__uint_as_float(r32[0]), __uint_as_float(r32[1]));
      }
      const float mold = (m == 0) ? mrun0 : mrun1;
      const bool moved = __builtin_amdgcn_ballot_w64(mx > mold + 8.f) != 0ull;
      const float mnew = moved ? fmaxf(mold, mx) : mold;
      if (m == 0) mrun0 = mnew; else mrun1 = mnew;
      float ps = 0.f;
      u32x4 u0, u1;
      {
        float e0 = __builtin_amdgcn_exp2f(sacc[m][0][0] - mnew), e1 = __builtin_amdgcn_exp2f(sacc[m][0][1] - mnew), e2 = __builtin_amdgcn_exp2f(sacc[m][0][2] - mnew), e3 = __builtin_amdgcn_exp2f(sacc[m][0][3] - mnew);
        ps += (e0 + e1) + (e2 + e3); u0.x = pack2(e0, e1); u0.y = pack2(e2, e3);
      }
      {
        float e0 = __builtin_amdgcn_exp2f(sacc[m][1][0] - mnew), e1 = __builtin_amdgcn_exp2f(sacc[m][1][1] - mnew), e2 = __builtin_amdgcn_exp2f(sacc[m][1][2] - mnew), e3 = __builtin_amdgcn_exp2f(sacc[m][1][3] - mnew);
        ps += (e0 + e1) + (e2 + e3); u0.z = pack2(e0, e1); u0.w = pack2(e2, e3);
      }
      {
        float e0 = __builtin_amdgcn_exp2f(sacc[m][2][0] - mnew), e1 = __builtin_amdgcn_exp2f(sacc[m][2][1] - mnew), e2 = __builtin_amdgcn_exp2f(sacc[m][2][2] - mnew), e3 = __builtin_amdgcn_exp2f(sacc[m][2][3] - mnew);
        ps += (e0 + e1) + (e2 + e3); u1.x = pack2(e0, e1); u1.y = pack2(e2, e3);
      }
      {
        float e0 = __builtin_amdgcn_exp2f(sacc[m][3][0] - mnew), e1 = __builtin_amdgcn_exp2f(sacc[m][3][1] - mnew), e2 = __builtin_amdgcn_exp2f(sacc[m][3][2] - mnew), e3 = __builtin_amdgcn_exp2f(sacc[m][3][3] - mnew);
        ps += (e0 + e1) + (e2 + e3); u1.z = pack2(e0, e1); u1.w = pack2(e2, e3);
      }
      if (moved) {
        const float alpha = __builtin_amdgcn_exp2f(mold - mnew);
        if (m == 0) lsum0 *= alpha; else lsum1 *= alpha;
#pragma unroll
        for (int t = 0; t < 8; ++t) { oacc[m][t][0] *= alpha; oacc[m][t][1] *= alpha; oacc[m][t][2] *= alpha; oacc[m][t][3] *= alpha; }
      }
      if (m == 0) lsum0 += ps; else lsum1 += ps;
      pf[m][0] = __builtin_bit_cast(bf16x8, u0);
      pf[m][1] = __builtin_bit_cast(bf16x8, u1);
    }
    __builtin_amdgcn_sched_barrier(0);
    if (!late) pv(sV);
    if (kt + 1 < ntile) {
      bf16_t* nK = sK0 + ((kt + 1) & 1) * KBUF;
      bf16_t* nV = sV0 + ((kt + 1) % 3) * VBUF;
#pragma unroll
      for (int i = 0; i < 2; ++i) { *(u32x4*)(nK + KLDS(i)) = rk[i]; *(u32x4*)(nV + vldsoff0 + i * 64 * LDV) = rv[i]; }
    }
    __syncthreads();
  }
  if (late) pv(sV0 + ((ntile - 1) % 3) * VBUF);
  float l0 = lsum0, l1 = lsum1;
  l0 += __shfl_xor(l0, 16); l0 += __shfl_xor(l0, 32);
  l1 += __shfl_xor(l1, 16); l1 += __shfl_xor(l1, 32);
  const float i0 = 1.f / l0, i1 = lam / l1;
  float ss = 0.f;
#pragma unroll
  for (int t = 0; t < 8; ++t)
#pragma unroll
    for (int j = 0; j < 4; ++j) {
      float o = oacc[0][t][j] * i0 - oacc[1][t][j] * i1;
      oacc[0][t][j] = o;
      ss += o * o;
    }
  ss += __shfl_xor(ss, 16); ss += __shfl_xor(ss, 32);
  const float rstd = rsqrtf(ss * (1.f / 128.f) + 1e-6f) * (1.f - lam_init);
  const float* sg = p.da_subln_g + layer * 128;
#pragma unroll
  for (int t = 0; t < 8; ++t) {
    int dv = t * 16 + quad * 4;
    float4 g = *(const float4*)(sg + dv);
    *(u32x2*)(p.Abuf + (size_t)qrow * D + h * 128 + dv) =
        mk2(pack2(oacc[0][t][0] * rstd * g.x, oacc[0][t][1] * rstd * g.y), pack2(oacc[0][t][2] * rstd * g.z, oacc[0][t][3] * rstd * g.w));
  }
}

DI float red16(float v) {
  v += __int_as_float(__builtin_amdgcn_update_dpp(0, __float_as_int(v), 0xB1, 0xF, 0xF, true));
  v += __int_as_float(__builtin_amdgcn_update_dpp(0, __float_as_int(v), 0x4E, 0xF, 0xF, true));
  v += __int_as_float(__builtin_amdgcn_update_dpp(0, __float_as_int(v), 0x141, 0xF, 0xF, true));
  v += __int_as_float(__builtin_amdgcn_update_dpp(0, __float_as_int(v), 0x140, 0xF, 0xF, true));
  return v;
}
DI float red8(float v) {
  v += __int_as_float(__builtin_amdgcn_update_dpp(0, __float_as_int(v), 0xB1, 0xF, 0xF, true));
  v += __int_as_float(__builtin_amdgcn_update_dpp(0, __float_as_int(v), 0x4E, 0xF, 0xF, true));
  v += __int_as_float(__builtin_amdgcn_update_dpp(0, __float_as_int(v), 0x141, 0xF, 0xF, true));
  return v;
}
constexpr int SC2_Q = 0, SC2_K = 2048, SC2_V = 4096, SC2_A = 6144, SC2_O = 6272, SC2_BUF = 8320;
template <int MX>
DI void scan_item(const Params& p, int layer, int dir, int b, int h, float* sm) {
  const int tfull = tidx();
  const bool stager = tfull >= 256;
  const int tid = tfull & 255;
  const int e = tid >> 2, part = tid & 3;
  const int pl = tid >> 3, p8 = tid & 7;
  const int slot_w = dir == 0 ? pl : 31 - pl;
  f32x2 s2[8];
#pragma unroll
  for (int d = 0; d < 8; ++d) s2[d] = (f32x2){0.f, 0.f};
  float lbf[8], oml[8];
  float gA = 0.f, gdt = 0.f;
  if (MX == 0) {
#pragma unroll
    for (int d = 0; d < 8; ++d) {
      float lb = 0.f;
      if (layer == 1) {
        int ci = dir * 256 + h * 64 + p8 * 8 + d;
        float l0 = p.hg_lb_logits[ci], l1 = p.hg_lb_logits[512 + ci];
        lb = 1.f / (1.f + expf(l0 - l1));
      }
      lbf[d] = fmaxf(lb, 1e-30f);
      oml[d] = 1.f - lb;
    }
  } else {
    gA = expf(p.gd_a_log[layer * 8 + dir * 4 + h]);
    gdt = p.gd_dt_bias[layer * 8 + dir * 4 + h];
  }
  const float* cw = p.gd_conv_w + (size_t)layer * 3 * 768;
  u32x4 rq[3], rk[3], rv[3];
  float ra_ = 0.f, rb_ = 0.f;
  const u32x4 z4 = {0u, 0u, 0u, 0u};
#pragma unroll
  for (int j = 0; j < 3; ++j) { rq[j] = z4; rk[j] = z4; rv[j] = z4; }

#define SCAN_CHUNK_GEOM(c)                                                   \
  const int seg_ = (c) < 8 ? 0 : 1;                                          \
  const int L_ = seg_ == 0 ? CTXL : SEQ;                                     \
  const int rowbase_ = seg_ == 0 ? NLAT + b * CTXL : b * SEQ;                \
  const int ci_ = seg_ == 0 ? (c) : (c) - 8;                                 \
  const int p0_ = dir == 0 ? ci_ * 32 : L_ - 32 * (ci_ + 1);

  auto load_raw = [&](int c) {
    SCAN_CHUNK_GEOM(c)
    const int pos = p0_ + pl;
    const bf16_t* prow = p.P + (size_t)(rowbase_ + pos) * PW;
    if (MX == 0) {
      rq[0] = *(const u32x4*)(prow + PC_HQ + h * 64 + p8 * 8);
      rk[0] = *(const u32x4*)(prow + PC_HF + dir * 256 + h * 64 + p8 * 8);
      rv[0] = *(const u32x4*)(prow + PC_HI + h * 64 + p8 * 8);
    } else {
#pragma unroll
      for (int j = 0; j < 3; ++j) {
        const int pp = pos + j - 1;
        const bool ok = (pp >= 0 && pp < L_);
        const bf16_t* pr = p.P + (size_t)(rowbase_ + pp) * PW + PC_GQKV + h * 64 + p8 * 8;
        rq[j] = ok ? *(const u32x4*)(pr) : z4;
        rk[j] = ok ? *(const u32x4*)(pr + 256) : z4;
        rv[j] = ok ? *(const u32x4*)(pr + 512) : z4;
      }
      if (p8 == 0) { ra_ = bf2f(prow[PC_GA + dir * 4 + h]); rb_ = bf2f(prow[PC_GB + dir * 4 + h]); }
    }
  };
  auto compute_store = [&](float* buf) {
    float* sq = buf + SC2_Q + slot_w * 64 + p8 * 8;
    float* sk = buf + SC2_K + slot_w * 64 + p8 * 8;
    float* sv = buf + SC2_V + slot_w * 64 + p8 * 8;
    if (MX == 0) {
      float qv[8], fv[8], iv[8];
      unpack8(rq[0], qv); unpack8(rk[0], fv); unpack8(rv[0], iv);
      f32x4 o0, o1, f0, f1;
#pragma unroll
      for (int d = 0; d < 4; ++d) {
        o0[d] = qv[d] * __builtin_amdgcn_rcpf(1.f + __expf(-qv[d])); o1[d] = qv[4 + d] * __builtin_amdgcn_rcpf(1.f + __expf(-qv[4 + d]));
        f0[d] = lbf[d] + oml[d] * __builtin_amdgcn_rcpf(1.f + __expf(-fv[d])); f1[d] = lbf[4 + d] + oml[4 + d] * __builtin_amdgcn_rcpf(1.f + __expf(-fv[4 + d]));
      }
      *(f32x4*)(sq) = o0; *(f32x4*)(sq + 4) = o1;
      *(f32x4*)(sk) = f0; *(f32x4*)(sk + 4) = f1;
      const f32x4 v0 = {iv[0], iv[1], iv[2], iv[3]}, v1 = {iv[4], iv[5], iv[6], iv[7]};
      *(f32x4*)(sv) = v0; *(f32x4*)(sv + 4) = v1;
    } else {
      float yq[8], yk[8], yv[8];
#pragma unroll
      for (int d = 0; d < 8; ++d) { yq[d] = 0.f; yk[d] = 0.f; yv[d] = 0.f; }
#pragma unroll
      for (int j = 0; j < 3; ++j) {
        float xq[8], xk[8], xv[8];
        unpack8(rq[j], xq); unpack8(rk[j], xk); unpack8(rv[j], xv);
        const float* cq = cw + j * 768 + h * 64 + p8 * 8;
        const f32x4 wq0 = *(const f32x4*)(cq), wq1 = *(const f32x4*)(cq + 4);
        const f32x4 wk0 = *(const f32x4*)(cq + 256), wk1 = *(const f32x4*)(cq + 260);
        const f32x4 wv0 = *(const f32x4*)(cq + 512), wv1 = *(const f32x4*)(cq + 516);
#pragma unroll
        for (int d = 0; d < 4; ++d) {
          yq[d] += xq[d] * wq0[d]; yq[4 + d] += xq[4 + d] * wq1[d];
          yk[d] += xk[d] * wk0[d]; yk[4 + d] += xk[4 + d] * wk1[d];
          yv[d] += xv[d] * wv0[d]; yv[4 + d] += xv[4 + d] * wv1[d];
        }
      }
      float sq2 = 0.f, sk2 = 0.f;
#pragma unroll
      for (int d = 0; d < 8; ++d) {
        yq[d] = yq[d] * __builtin_amdgcn_rcpf(1.f + __expf(-yq[d]));
        yk[d] = yk[d] * __builtin_amdgcn_rcpf(1.f + __expf(-yk[d]));
        yv[d] = yv[d] * __builtin_amdgcn_rcpf(1.f + __expf(-yv[d]));
        sq2 += yq[d] * yq[d]; sk2 += yk[d] * yk[d];
      }
      sq2 = red8(sq2); sk2 = red8(sk2);
      const float rqn = rsqrtf(sq2 + 1e-6f) * 0.125f, rkn = rsqrtf(sk2 + 1e-6f);
      float qk = 0.f;
      f32x4 o0, o1, k0, k1;
#pragma unroll
      for (int d = 0; d < 4; ++d) {
        o0[d] = yq[d] * rqn; o1[d] = yq[4 + d] * rqn; k0[d] = yk[d] * rkn; k1[d] = yk[4 + d] * rkn;
        qk += o0[d] * k0[d] + o1[d] * k1[d];
      }
      qk = red8(qk);
      *(f32x4*)(sq) = o0; *(f32x4*)(sq + 4) = o1;
      *(f32x4*)(sk) = k0; *(f32x4*)(sk + 4) = k1;
      const f32x4 v0 = {yv[0], yv[1], yv[2], yv[3]}, v1 = {yv[4], yv[5], yv[6], yv[7]};
      *(f32x4*)(sv) = v0; *(f32x4*)(sv + 4) = v1;
      if (p8 == 0) {
        const float xx = ra_ + gdt;
        const float y = __expf(xx);
        const float sp = xx > 15.f ? xx : (y < 1e-3f ? y * (1.f - 0.5f * y) : __logf(1.f + y));
        const f32x4 rec = {__expf(-gA * sp), __builtin_amdgcn_rcpf(1.f + __expf(-rb_)), qk, 0.f};
        *(f32x4*)(buf + SC2_A + slot_w * 4) = rec;
      }
    }
  };
  auto write_out = [&](int c) {
    SCAN_CHUNK_GEOM(c)
    const float* so = sm + (c & 1) * SC2_BUF + SC2_O + slot_w * 64 + p8 * 8;
    const f32x4 a0 = *(const f32x4*)so, a1 = *(const f32x4*)(so + 4);
    bf16_t* dst = p.raw + ((size_t)((MX * 2 + dir) * NROW + rowbase_ + p0_ + pl)) * 256 + h * 64 + p8 * 8;
    *(u32x4*)dst = mk4(pack2(a0[0], a0[1]), pack2(a0[2], a0[3]), pack2(a1[0], a1[1]), pack2(a1[2], a1[3]));
  };

  constexpr int NCH = 8 + 64;
  __syncthreads();
  if (stager) { load_raw(0); compute_store(sm); }
  __syncthreads();
  if (!stager) __builtin_amdgcn_s_setprio(3);
  for (int c = 0; c < NCH; ++c) {
    if (stager) {
      if (c + 1 < NCH) load_raw(c + 1);
      if (c > 0) write_out(c - 1);
      if (c + 1 < NCH) compute_store(sm + ((c + 1) & 1) * SC2_BUF);
    } else {
      const float* buf = sm + (c & 1) * SC2_BUF;
      const float* sq = buf + SC2_Q + part * 16;
      const float* sk = buf + SC2_K + part * 16;
      const float* sv = buf + SC2_V + e;
      const float* sa = buf + SC2_A;
      float* so = sm + (c & 1) * SC2_BUF + SC2_O + e;
      f32x4 qn[4], kn[4];
      float vnx;
      f32x4 recn = {0.f, 0.f, 0.f, 0.f};
#pragma unroll
      for (int u = 0; u < 4; ++u) { qn[u] = *(const f32x4*)(sq + 4 * u); kn[u] = *(const f32x4*)(sk + 4 * u); }
      vnx = sv[0];
      if (MX == 1) recn = *(const f32x4*)(sa);
#pragma unroll
      for (int i = 0; i < 32; ++i) {
        f32x4 q[4], k[4];
#pragma unroll
        for (int u = 0; u < 4; ++u) { q[u] = qn[u]; k[u] = kn[u]; }
        const float vv = vnx;
        const f32x4 rec = recn;
        const int il = (i < 31) ? i + 1 : i;
#pragma unroll
        for (int u = 0; u < 4; ++u) { qn[u] = *(const f32x4*)(sq + il * 64 + 4 * u); kn[u] = *(const f32x4*)(sk + il * 64 + 4 * u); }
        vnx = sv[il * 64];
        if (MX == 1) recn = *(const f32x4*)(sa + il * 4);
        float o;
        if (MX == 0) {
          const f32x2 vv2 = {vv, vv};
          f32x2 acc2 = {0.f, 0.f};
#pragma unroll
          for (int u = 0; u < 4; ++u) {
            const f32x2 klo = {k[u][0], k[u][1]}, khi = {k[u][2], k[u][3]};
            const f32x2 qlo = {q[u][0], q[u][1]}, qhi = {q[u][2], q[u][3]};
            s2[2 * u] = vv2 + klo * (s2[2 * u] - vv2);
            s2[2 * u + 1] = vv2 + khi * (s2[2 * u + 1] - vv2);
            acc2 += s2[2 * u] * qlo;
            acc2 += s2[2 * u + 1] * qhi;
          }
          o = quad_sum(acc2[0] + acc2[1]);
        } else {
          const float al = rec[0], be = rec[1], qk = rec[2];
          f32x2 ks2 = {0.f, 0.f}, qs2 = {0.f, 0.f};
#pragma unroll
          for (int u = 0; u < 4; ++u) {
            const f32x2 klo = {k[u][0], k[u][1]}, khi = {k[u][2], k[u][3]};
            const f32x2 qlo = {q[u][0], q[u][1]}, qhi = {q[u][2], q[u][3]};
            ks2 += klo * s2[2 * u]; ks2 += khi * s2[2 * u + 1];
            qs2 += qlo * s2[2 * u]; qs2 += qhi * s2[2 * u + 1];
          }
          const float ks = quad_sum(ks2[0] + ks2[1]), qs = quad_sum(qs2[0] + qs2[1]);
          const float vn = be * (vv - al * ks);
          const f32x2 al2 = {al, al}, vn2 = {vn, vn};
#pragma unroll
          for (int u = 0; u < 4; ++u) {
            const f32x2 klo = {k[u][0], k[u][1]}, khi = {k[u][2], k[u][3]};
            s2[2 * u] = al2 * s2[2 * u] + klo * vn2;
            s2[2 * u + 1] = al2 * s2[2 * u + 1] + khi * vn2;
          }
          o = al * qs + qk * vn;
        }
        so[i * 64] = o;
      }
    }
    __syncthreads();
  }
  __builtin_amdgcn_s_setprio(0);
  if (stager) write_out(NCH - 1);
}

constexpr int GD_QK = 4224;
constexpr int GD_V = 3 * GD_QK;
constexpr int GD_VNT = GD_V + 2 * 2048;
constexpr int GD_S0 = GD_VNT + 2 * 2048;
constexpr int GD_GC = GD_S0 + 2 * 2048;
constexpr int GD_QKB = GD_GC + 128;
DI bf16x8 cvt8(const f32x4 a, const f32x4 b) {
  const u32x4 u = mk4(pack2(a[0], a[1]), pack2(a[2], a[3]), pack2(b[0], b[1]), pack2(b[2], b[3]));
  return __builtin_bit_cast(bf16x8, u);
}
DI void scan_item_gdn(const Params& p, int layer, int dir, int b, int h, float* sm) {
  const int tfull = tidx();
  const bool stager = tfull >= 256;
  const int tid = tfull & 255;
  const int e = tid >> 2, part = tid & 3;
  const int pl = tid >> 3, p8 = tid & 7;
  const int slot_w = dir == 0 ? pl : 31 - pl;
  const int sw = tid >> 6, lane = tid & 63, l15 = lane & 15, g = lane >> 4;
  f32x2 s2[8];
#pragma unroll
  for (int d = 0; d < 8; ++d) s2[d] = (f32x2){0.f, 0.f};
  const float gA = expf(p.gd_a_log[layer * 8 + dir * 4 + h]);
  const float gdt = p.gd_dt_bias[layer * 8 + dir * 4 + h];
  const float* cw = p.gd_conv_w + (size_t)layer * 3 * 768;
  u32x4 rq[3], rk[3], rv[3];
  float ra_ = 0.f, rb_ = 0.f;
  const u32x4 z4 = {0u, 0u, 0u, 0u};
#pragma unroll
  for (int j = 0; j < 3; ++j) { rq[j] = z4; rk[j] = z4; rv[j] = z4; }

#define GDN_CHUNK_GEOM(c)                                                    \
  const int seg_ = (c) < 8 ? 0 : 1;                                          \
  const int L_ = seg_ == 0 ? CTXL : SEQ;                                     \
  const int rowbase_ = seg_ == 0 ? NLAT + b * CTXL : b * SEQ;                \
  const int ci_ = seg_ == 0 ? (c) : (c) - 8;                                 \
  const int p0_ = dir == 0 ? ci_ * 32 : L_ - 32 * (ci_ + 1);

  auto load_raw = [&](int c) {
    GDN_CHUNK_GEOM(c)
    const int pos = p0_ + pl;
    const bf16_t* prow = p.P + (size_t)(rowbase_ + pos) * PW;
#pragma unroll
    for (int j = 0; j < 3; ++j) {
      const int pp = pos + j - 1;
      const bool ok = (pp >= 0 && pp < L_);
      const bf16_t* pr = p.P + (size_t)(rowbase_ + pp) * PW + PC_GQKV + h * 64 + p8 * 8;
      rq[j] = ok ? *(const u32x4*)(pr) : z4;
      rk[j] = ok ? *(const u32x4*)(pr + 256) : z4;
      rv[j] = ok ? *(const u32x4*)(pr + 512) : z4;
    }
    if (p8 == 0) { ra_ = bf2f(prow[PC_GA + dir * 4 + h]); rb_ = bf2f(prow[PC_GB + dir * 4 + h]); }
  };
  auto compute_store = [&](int c) {
    float* qk = sm + (c % 3) * GD_QK;
    float* sq = qk + slot_w * 64 + p8 * 8;
    float* sk = qk + 2048 + slot_w * 64 + p8 * 8;
    float* sv = sm + GD_V + (c & 1) * 2048 + slot_w * 64 + p8 * 8;
    float yq[8], yk[8], yv[8];
#pragma unroll
    for (int d = 0; d < 8; ++d) { yq[d] = 0.f; yk[d] = 0.f; yv[d] = 0.f; }
#pragma unroll
    for (int j = 0; j < 3; ++j) {
      float xq[8], xk[8], xv[8];
      unpack8(rq[j], xq); unpack8(rk[j], xk); unpack8(rv[j], xv);
      const float* cq = cw + j * 768 + h * 64 + p8 * 8;
      const f32x4 wq0 = *(const f32x4*)(cq), wq1 = *(const f32x4*)(cq + 4);
      const f32x4 wk0 = *(const f32x4*)(cq + 256), wk1 = *(const f32x4*)(cq + 260);
      const f32x4 wv0 = *(const f32x4*)(cq + 512), wv1 = *(const f32x4*)(cq + 516);
#pragma unroll
      for (int d = 0; d < 4; ++d) {
        yq[d] += xq[d] * wq0[d]; yq[4 + d] += xq[4 + d] * wq1[d];
        yk[d] += xk[d] * wk0[d]; yk[4 + d] += xk[4 + d] * wk1[d];
        yv[d] += xv[d] * wv0[d]; yv[4 + d] += xv[4 + d] * wv1[d];
      }
    }
    float sq2 = 0.f, sk2 = 0.f;
#pragma unroll
    for (int d = 0; d < 8; ++d) {
      yq[d] = yq[d] * __builtin_amdgcn_rcpf(1.f + __expf(-yq[d]));
      yk[d] = yk[d] * __builtin_amdgcn_rcpf(1.f + __expf(-yk[d]));
      yv[d] = yv[d] * __builtin_amdgcn_rcpf(1.f + __expf(-yv[d]));
      sq2 += yq[d] * yq[d]; sk2 += yk[d] * yk[d];
    }
    sq2 = red8(sq2); sk2 = red8(sk2);
    const float rqn = rsqrtf(sq2 + 1e-6f) * 0.125f, rkn = rsqrtf(sk2 + 1e-6f);
    f32x4 o0, o1, k0, k1;
#pragma unroll
    for (int d = 0; d < 4; ++d) { o0[d] = yq[d] * rqn; o1[d] = yq[4 + d] * rqn; k0[d] = yk[d] * rkn; k1[d] = yk[4 + d] * rkn; }
    *(f32x4*)(sq) = o0; *(f32x4*)(sq + 4) = o1;
    *(f32x4*)(sk) = k0; *(f32x4*)(sk + 4) = k1;
    {
      bf16_t* qkb = (bf16_t*)(sm + GD_QKB + (c % 3) * 2048);
      *(bf16x8*)(qkb + slot_w * 64 + p8 * 8) = cvt8(o0, o1);
      *(bf16x8*)(qkb + 2048 + slot_w * 64 + p8 * 8) = cvt8(k0, k1);
    }
    const f32x4 v0 = {yv[0], yv[1], yv[2], yv[3]}, v1 = {yv[4], yv[5], yv[6], yv[7]};
    *(f32x4*)(sv) = v0; *(f32x4*)(sv + 4) = v1;
    if (p8 == 0) {
      const float xx = ra_ + gdt;
      const float y = __expf(xx);
      const float sp = xx > 15.f ? xx : (y < 1e-3f ? y * (1.f - 0.5f * y) : __logf(1.f + y));
      const float la = fmaxf(-gA * sp * 1.4426950408889634f, -115.f);
      const f32x4 rec = {__expf(-gA * sp), __builtin_amdgcn_rcpf(1.f + __expf(-rb_)), la, 0.f};
      *(f32x4*)(qk + 4096 + slot_w * 4) = rec;
    }
  };
  auto output = [&](int c) {
    GDN_CHUNK_GEOM(c)
    const float* qk = sm + (c % 3) * GD_QK;
    const float* sq = qk;
    const float* sk = qk + 2048;
    const float* rec = qk + 4096;
    const float* vnt = sm + GD_VNT + (c & 1) * 2048;
    const bf16_t* s0t = (const bf16_t*)(sm + GD_S0 + (c & 1) * 2048);
    float* gcs = sm + GD_GC + sw * 32;
    {
      float x = (lane < 32) ? rec[lane * 4 + 2] : 0.f;
#pragma unroll
      for (int off = 1; off < 32; off <<= 1) { const float t = __shfl_up(x, off); if (lane >= off) x += t; }
      if (lane < 32) gcs[lane] = x;
    }
    const float gct0 = gcs[l15], gct1 = gcs[16 + l15];
    const float eg0 = __builtin_amdgcn_exp2f(gct0), eg1 = __builtin_amdgcn_exp2f(gct1);
    const bf16_t* qb = (const bf16_t*)(sm + GD_QKB + (c % 3) * 2048);
    const bf16_t* kb = qb + 2048;
    bf16x8 qf[2][2];
#pragma unroll
    for (int n = 0; n < 2; ++n)
#pragma unroll
      for (int kk = 0; kk < 2; ++kk) qf[n][kk] = *(const bf16x8*)(qb + (16 * n + l15) * 64 + 32 * kk + 8 * g);
    f32x4 acc[2];
#pragma unroll
    for (int n = 0; n < 2; ++n) acc[n] = (f32x4){0.f, 0.f, 0.f, 0.f};
#pragma unroll
    for (int kk = 0; kk < 2; ++kk) {
      const bf16x8 a = *(const bf16x8*)(s0t + (16 * sw + l15) * 64 + 32 * kk + 8 * g);
      acc[0] = __builtin_amdgcn_mfma_f32_16x16x32_bf16(a, qf[0][kk], acc[0], 0, 0, 0);
      acc[1] = __builtin_amdgcn_mfma_f32_16x16x32_bf16(a, qf[1][kk], acc[1], 0, 0, 0);
    }
    acc[0] *= eg0; acc[1] *= eg1;
    f32x4 wt[2][2];
#pragma unroll
    for (int m = 0; m < 2; ++m)
#pragma unroll
      for (int n = 0; n < 2; ++n) wt[m][n] = (f32x4){0.f, 0.f, 0.f, 0.f};
#pragma unroll
    for (int m = 0; m < 2; ++m)
#pragma unroll
      for (int kk = 0; kk < 2; ++kk) {
        const bf16x8 a = *(const bf16x8*)(kb + (16 * m + l15) * 64 + 32 * kk + 8 * g);
        if (m == 0) wt[0][0] = __builtin_amdgcn_mfma_f32_16x16x32_bf16(a, qf[0][kk], wt[0][0], 0, 0, 0);
        wt[m][1] = __builtin_amdgcn_mfma_f32_16x16x32_bf16(a, qf[1][kk], wt[m][1], 0, 0, 0);
      }
#pragma unroll
    for (int m = 0; m < 2; ++m) {
      const f32x4 gs = *(const f32x4*)(gcs + 16 * m + 4 * g);
#pragma unroll
      for (int n = 0; n < 2; ++n) {
        if (m == 1 && n == 0) continue;
        const float gt = n == 0 ? gct0 : gct1;
        const int t = 16 * n + l15;
#pragma unroll
        for (int j = 0; j < 4; ++j) {
          const int s_ = 16 * m + 4 * g + j;
          wt[m][n][j] = (s_ <= t) ? wt[m][n][j] * __builtin_amdgcn_exp2f(gt - gs[j]) : 0.f;
        }
      }
    }
    {
      const float* vsrc = vnt + (16 * sw + l15) * 32 + 4 * g;
      const bf16x8 a = cvt8(*(const f32x4*)vsrc, *(const f32x4*)(vsrc + 16));
#pragma unroll
      for (int n = 0; n < 2; ++n) {
        const bf16x8 bw = cvt8(wt[0][n], wt[1][n]);
        acc[n] = __builtin_amdgcn_mfma_f32_16x16x32_bf16(a, bw, acc[n], 0, 0, 0);
      }
    }
#pragma unroll
    for (int n = 0; n < 2; ++n) {
      const int t = 16 * n + l15;
      const int pos = p0_ + (dir == 0 ? t : 31 - t);
      bf16_t* dst = p.raw + ((size_t)((1 * 2 + dir) * NROW + rowbase_ + pos)) * 256 + h * 64 + 16 * sw + 4 * g;
      *(u32x2*)dst = mk2(pack2(acc[n][0], acc[n][1]), pack2(acc[n][2], acc[n][3]));
    }
  };

  constexpr int NCH = 8 + 64;
  __syncthreads();
  if (stager) { load_raw(0); compute_store(0); }
  __syncthreads();
  if (!stager) __builtin_amdgcn_s_setprio(3);
  for (int c = 0; c < NCH; ++c) {
    if (stager) {
      if (c + 1 < NCH) load_raw(c + 1);
      if (c > 0) output(c - 1);
      if (c + 1 < NCH) compute_store(c + 1);
    } else {
      const float* qk = sm + (c % 3) * GD_QK;
      const float* sq = qk + part * 16;
      const float* sk = qk + 2048 + part * 16;
      const float* sa = qk + 4096;
      const float* sv = sm + GD_V + (c & 1) * 2048 + e;
      float* vnt = sm + GD_VNT + (c & 1) * 2048 + e * 32;
      {
        bf16_t* s0 = (bf16_t*)(sm + GD_S0 + (c & 1) * 2048) + e * 64 + part * 16;
        *(u32x4*)s0 = mk4(pack2(s2[0][0], s2[0][1]), pack2(s2[1][0], s2[1][1]), pack2(s2[2][0], s2[2][1]), pack2(s2[3][0], s2[3][1]));
        *(u32x4*)(s0 + 8) = mk4(pack2(s2[4][0], s2[4][1]), pack2(s2[5][0], s2[5][1]), pack2(s2[6][0], s2[6][1]), pack2(s2[7][0], s2[7][1]));
      }
      f32x4 kn[4];
      float vnx;
      f32x4 recn;
#pragma unroll
      for (int u = 0; u < 4; ++u) kn[u] = *(const f32x4*)(sk + 4 * u);
      vnx = sv[0];
      recn = *(const f32x4*)(sa);
#pragma unroll
      for (int i = 0; i < 32; ++i) {
        f32x4 k[4];
#pragma unroll
        for (int u = 0; u < 4; ++u) k[u] = kn[u];
        const float vv = vnx;
        const f32x4 rec = recn;
        const int il = (i < 31) ? i + 1 : i;
#pragma unroll
        for (int u = 0; u < 4; ++u) kn[u] = *(const f32x4*)(sk + il * 64 + 4 * u);
        vnx = sv[il * 64];
        recn = *(const f32x4*)(sa + il * 4);
        const float al = rec[0], be = rec[1];
        f32x2 ks2 = {0.f, 0.f};
#pragma unroll
        for (int u = 0; u < 4; ++u) {
          const f32x2 klo = {k[u][0], k[u][1]}, khi = {k[u][2], k[u][3]};
          ks2 += klo * s2[2 * u]; ks2 += khi * s2[2 * u + 1];
        }
        const float ks = quad_sum(ks2[0] + ks2[1]);
        const float vn = be * (vv - al * ks);
        const f32x2 al2 = {al, al}, vn2 = {vn, vn};
#pragma unroll
        for (int u = 0; u < 4; ++u) {
          const f32x2 klo = {k[u][0], k[u][1]}, khi = {k[u][2], k[u][3]};
          s2[2 * u] = al2 * s2[2 * u] + klo * vn2;
          s2[2 * u + 1] = al2 * s2[2 * u + 1] + khi * vn2;
        }
        vnt[i] = vn;
      }
      (void)sq;
    }
    __syncthreads();
  }
  __builtin_amdgcn_s_setprio(0);
  if (stager) output(NCH - 1);
}

DI void finish_phase(const Params& p, int layer) {
  const int lane = tidx() & 63, wid = tidx() >> 6;
  const int nrows = (layer == 1) ? NLAT : NROW;
  for (int idx = bidx() * NWAVE + wid; idx < nrows * 2; idx += gridDim.x * NWAVE) {
    const int row = idx >> 1, mx = idx & 1;
    u32x2 uf = __builtin_nontemporal_load((const u32x2*)(p.raw + ((size_t)((mx * 2 + 0) * NROW + row)) * 256 + lane * 4));
    u32x2 ub = __builtin_nontemporal_load((const u32x2*)(p.raw + ((size_t)((mx * 2 + 1) * NROW + row)) * 256 + lane * 4));
    float o[4];
    o[0] = __uint_as_float(uf.x << 16) + __uint_as_float(ub.x << 16);
    o[1] = __uint_as_float(uf.x & 0xffff0000u) + __uint_as_float(ub.x & 0xffff0000u);
    o[2] = __uint_as_float(uf.y << 16) + __uint_as_float(ub.y << 16);
    o[3] = __uint_as_float(uf.y & 0xffff0000u) + __uint_as_float(ub.y & 0xffff0000u);
    float ss = o[0] * o[0] + o[1] * o[1] + o[2] * o[2] + o[3] * o[3];
    ss += __shfl_xor(ss, 1); ss += __shfl_xor(ss, 2); ss += __shfl_xor(ss, 4); ss += __shfl_xor(ss, 8);
    const float rstd = rsqrtf(ss * (1.f / 64.f) + 1e-6f);
    u32x2 ug = *(const u32x2*)(p.P + (size_t)row * PW + (mx == 0 ? PC_HG : PC_GG) + lane * 4);
    float g[4] = {__uint_as_float(ug.x << 16), __uint_as_float(ug.x & 0xffff0000u), __uint_as_float(ug.y << 16), __uint_as_float(ug.y & 0xffff0000u)};
    const float* ng = (mx == 0 ? p.hg_norm_g : p.gd_norm_g) + layer * 64 + (lane & 15) * 4;
    float r[4];
#pragma unroll
    for (int j = 0; j < 4; ++j) r[j] = (o[j] * rstd * ng[j]) * silu_f(g[j]);
    *(u32x2*)(p.Abuf + (size_t)row * D + 512 + mx * 256 + lane * 4) = mk2(pack2(r[0], r[1]), pack2(r[2], r[3]));
  }
}

DI void run_phase(const Params& p, int ph, char* smem) {
  const int bid = bidx(), G = gridDim.x;
  LAS unsigned char* lds = (LAS unsigned char*)smem;
  if (ph == 0) {
    for (int pr = bid; pr < (WT_IN + 1) / 2; pr += G) weight_pair(p, 0, 0, WT_IN, pr, smem);
    for (int it = bid; it < 192; it += G) mod_item(p, it, (float*)smem);
    for (int it = bid; it < 64; it += G) rope_item(p, it);
    if (bid == G - 1) for (int i = tidx(); i < D / 2; i += NTHR) ((unsigned*)(p.Abuf + (size_t)NROW * D))[i] = 0u;
    return;
  }
  int layer, code;
  if (ph == 1) { layer = 0; code = 10; }
  else if (ph < 12) { layer = 0; code = ph - 2; }
  else { layer = 1; const int q = ph - 12; code = q < 5 ? q : q + 1; if (code == 9) code = 8; }
  bool do_mix = false, do_upd = false;
  const bf16_t* gA = nullptr; const bf16_t* gB = nullptr; int gK = 0, gnM = 0, gpm = 0, gG = 0, gc = 0;
  int uwhich = 0, umode = 0, ubofs = 0, unb = G;
  switch (code) {
    case 10: do_upd = true; uwhich = 0; break;
    case 0: {
      gemm_phase<EPI_P, 0>(p, layer, lds, p.Abuf, p.WinT, D, NROW / 256, INW / 256);
      gemm_phase<EPI_VT, 0>(p, layer, lds, p.WvT, p.Abuf, D, 2, NROW / 256);
      if (G == 256 && bid >= 144) for (int k = 0; k < WPRE / 112; ++k) weight_pair(p, layer, WT_IN, WT_ITEMS, (bid - 144) + k * 112, smem);
    } break;
    case 1: {
      const int nattn = (layer == 0) ? 512 + 64 : 512;
      const int wpre = (G == 256) ? WPRE : 0;
      const int nwa = (WT_ITEMS - WT_IN + 1) / 2 - wpre, nwb = (layer == 0) ? (WT_IN + 1) / 2 : 0;
      const int total = 128 + nattn + nwa + nwb;
      volatile int* slot = (volatile int*)(smem + SMEM_BYTES + 8);
#ifdef PROBE_MIX
      for (int rep = 0; rep < 2; ++rep)
#endif
      for (;;) {
        __syncthreads();
#ifdef PROBE_MIX
        if (tidx() == 0) *slot = (int)xb_add(&p.bar[XB_QUEUE(layer + 2 * rep)], 1u) + (rep == 1 && PROBE_MIX == 2 ? 128 : 0);
        __syncthreads();
        const int it = *slot;
        if (it >= ((rep == 1 && PROBE_MIX == 1) ? 128 : total)) break;
#else
        if (tidx() == 0) *slot = (int)xb_add(&p.bar[XB_QUEUE(layer)], 1u);
        __syncthreads();
        const int it = *slot;
        if (it >= total) break;
#endif
        if (it < 128) {
          const int mx = it & 1, dir = (it >> 1) & 1, h = (it >> 2) & 3, b = (it >> 4) & 7;
          if (mx == 0) scan_item<0>(p, layer, dir, b, h, (float*)smem); else scan_item_gdn(p, layer, dir, b, h, (float*)smem);
        } else if (it < 128 + nattn) attn_item(p, layer, it - 128, smem);
        else if (it < 128 + nattn + nwa) weight_pair(p, layer, WT_IN, WT_ITEMS, wpre + it - 128 - nattn, smem);
        else weight_pair(p, layer + 1, 0, WT_IN, it - 128 - nattn - nwa, smem);
      }
    } break;
    case 2: finish_phase(p, layer); break;
    case 3: do_mix = true; gA = p.Abuf; gB = p.WoutT; gK = D; gnM = NLAT / 256; break;
    case 4:
      if (layer == 0 && G > 64) {
        if (bid < 32) { do_mix = true; gA = p.Abuf; gB = p.WoutT; gK = D; gnM = NCTX / 256; gpm = NLAT / 256; gG = 32; gc = bid; }
        else { do_upd = true; uwhich = 1; umode = 1; ubofs = 32; unb = G - 32; }
      } else if (layer == 0) { do_mix = true; gA = p.Abuf; gB = p.WoutT; gK = D; gnM = NCTX / 256; gpm = NLAT / 256; }
      else { do_upd = true; uwhich = 1; }
      break;
    case 5: do_upd = true; uwhich = 1; umode = (G > 64) ? 2 : 0; break;
    case 6: gemm_phase<EPI_CONV, 1>(p, layer, lds, p.Abuf, p.WupT, D, (layer == 1) ? HB_NLAT / 4 : (HB_NLAT + HB_NCTX) / 4, 22); break;
    case 7: do_mix = true; gA = p.act; gB = p.WdownT; gK = DFF; gnM = NLAT / 256; break;
    case 8:
      if (layer == 0 && G > 64) {
        if (bid < 32) { do_mix = true; gA = p.act; gB = p.WdownT; gK = DFF; gnM = NCTX / 256; gpm = NLAT / 256; gG = 32; gc = bid; }
        else { do_upd = true; uwhich = 2; umode = 1; ubofs = 32; unb = G - 32; }
      } else if (layer == 0) { do_mix = true; gA = p.act; gB = p.WdownT; gK = DFF; gnM = NCTX / 256; gpm = NLAT / 256; }
      else { do_upd = true; uwhich = 2; }
      break;
    case 9: do_upd = true; uwhich = 2; umode = (G > 64) ? 2 : 0; break;
  }
  if (do_mix) gemm_phase<EPI_MIX, 0>(p, layer, lds, gA, gB, gK, gnM, 4, gpm, gG, gc);
  if (do_upd) update_phase(p, layer, uwhich, umode, ubofs, unb);
}

__global__ void __launch_bounds__(NTHR, 2) mega_kernel(Params p) {
  extern __shared__ __attribute__((aligned(16))) unsigned char lds_dyn[];
  char* smem = (char*)lds_dyn;
  volatile LAS unsigned* st = (volatile LAS unsigned*)((LAS unsigned char*)lds_dyn + SMEM_BYTES);
  if (threadIdx.x == 0) { st[0] = 0u; st[1] = 0u; st[2] = 0u; st[3] = 0u; }
  __syncthreads();
  XcdBarrier xb = xcd_barrier_post(p.bar, st);
  if (p.phase_end > 1000) cg::this_grid().sync();
  for (int ph = p.phase_begin; ph < p.phase_end; ++ph) {
    if (ph > p.phase_begin) xcd_barrier(xb);
    run_phase(p, ph, smem);
#ifdef PROBE_MASK
    if (ph >= 2 && ((PROBE_MASK >> ((ph - 2) & 7)) & 1)) { __syncthreads(); run_phase(p, ph, smem); }
    if (ph < 2 && (PROBE_MASK & 0x100)) { __syncthreads(); run_phase(p, ph, smem); }
#endif
  }
}

extern "C" void kernel_launch(void* const* d_in, const int* in_sizes, int n_in, void* d_out, int out_size, void* d_ws, size_t ws_size,
                              hipStream_t stream) {
  Params p{};
  p.x = (const float*)d_in[0]; p.c = (const float*)d_in[1]; p.ctx = (const float*)d_in[2]; p.c_ctx = (const float*)d_in[3];
  p.ada_w = (const float*)d_in[4]; p.ada_b = (const float*)d_in[5]; p.norm_g = (const float*)d_in[6]; p.w_in = (const float*)d_in[7];
  p.w_out = (const float*)d_in[8]; p.da_lambda = (const float*)d_in[9]; p.da_subln_g = (const float*)d_in[10];
  p.hg_lb_logits = (const float*)d_in[11]; p.hg_norm_g = (const float*)d_in[12]; p.gd_conv_w = (const float*)d_in[13];
  p.gd_a_log = (const float*)d_in[14]; p.gd_dt_bias = (const float*)d_in[15]; p.gd_norm_g = (const float*)d_in[16];
  p.ffn_w_up = (const float*)d_in[17]; p.ffn_conv_w = (const float*)d_in[18]; p.ffn_conv_b = (const float*)d_in[19];
  p.ffn_w_down = (const float*)d_in[20];
  p.out = (float*)d_out;
  char* w = (char*)d_ws;
  size_t off = 0;
  auto take = [&](size_t bytes) { char* r = w + off; off += (bytes + 255) & ~(size_t)255; return r; };
  p.WinT = (bf16_t*)take((size_t)INW * D * 2);
  p.WvT = (bf16_t*)take((size_t)512 * D * 2);
  p.WoutT = (bf16_t*)take((size_t)D * D * 2);
  p.WupT = (bf16_t*)take((size_t)2 * DFF * D * 2);
  p.WdownT = (bf16_t*)take((size_t)D * DFF * 2);
  p.mod = (float*)take((size_t)2 * 9 * 6144 * 4);
  p.ropec = (float*)take((size_t)SEQ * 32 * 4);
  p.ropes = (float*)take((size_t)SEQ * 32 * 4);
  p.cx = (float*)take((size_t)NCTX * D * 4);
  p.bar = (unsigned*)take((size_t)BAR_WORDS_TOTAL * 4);
  p.Abuf = (bf16_t*)take((size_t)(NROW + 8) * D * 2);
  char* region = w + off;
  p.P = (bf16_t*)region;
  p.Vt = (bf16_t*)(region + (size_t)NROW * PW * 2);
  p.raw = (bf16_t*)(region + (size_t)NROW * PW * 2 + (size_t)NB * 4 * 128 * NKEY * 2);
  p.mix = (bf16_t*)region;
  p.act = (bf16_t*)(region + (size_t)NROW * D * 4);

  static int grid_blocks = 0;
  if (!grid_blocks) {
    int dev = 0, cus = 0, per_cu = 0;
    (void)hipGetDevice(&dev);
    (void)hipDeviceGetAttribute(&cus, hipDeviceAttributeMultiprocessorCount, dev);
    if (hipFuncSetAttribute((const void*)mega_kernel, hipFuncAttributeMaxDynamicSharedMemorySize, LDS_TOTAL) != hipSuccess)
      fprintf(stderr, "hipFuncSetAttribute(MaxDynamicSharedMemorySize=%d) failed\n", LDS_TOTAL);
    (void)hipOccupancyMaxActiveBlocksPerMultiprocessor(&per_cu, (const void*)mega_kernel, NTHR, LDS_TOTAL);
    (void)hipGetLastError();
    grid_blocks = cus;
  }
  (void)hipMemsetAsync(p.bar, 0, (size_t)BAR_WORDS_TOTAL * 4, stream);
#ifdef MK_MULTI
  for (int ph = 0; ph < NPHASE; ++ph) {
    p.phase_begin = ph; p.phase_end = ph + 1;
    hipLaunchKernelGGL(mega_kernel, dim3(grid_blocks), dim3(NTHR), LDS_TOTAL, stream, p);
  }
#else
  p.phase_begin = 0; p.phase_end = NPHASE;
  void* args[] = {&p};
  hipError_t e = hipLaunchCooperativeKernel((void*)mega_kernel, dim3(grid_blocks), dim3(NTHR), args, LDS_TOTAL, stream);
  if (e != hipSuccess) fprintf(stderr, "cooperative launch failed: %s (grid %d)\n", hipGetErrorString(e), grid_blocks);
#endif
}
```
